# Optimizing an MI355X kernel written in HIP

```python
import math
import jax, jax.numpy as jnp
from jax import lax
import numpy as np

D_MODEL = 2048
BATCH = 1
SEQ = 16384
DEPTH = 2

GRID_W = 64
CTX_LEN = 256
N_EVEN = (DEPTH + 1) // 2
N_ODD = DEPTH // 2
EPS = 1e-6
NEG_INF = -1e30
N_MOD = 9

HEAD_DIM = 128
HY_WIDTH = D_MODEL // 2
HY_GROUPS = HY_WIDTH // HEAD_DIM
ATT_WIDTH = D_MODEL - HY_WIDTH
N_Q_HEADS = ATT_WIDTH // HEAD_DIM
N_KV_HEADS = N_Q_HEADS // 4
Q_PER_KV = N_Q_HEADS // N_KV_HEADS
WINDOW = 128
ATT_BLOCK = 128
ROPE_BASE = 10000.0
SHORT_CONV = 3
HY_BANDS = 16
HY_EMB = 1 + 2 * HY_BANDS
HY_FILTER_HIDDEN = 64
HY_DECAY_TARGET = 1e-2
HY_FAST_PCT = 0.3
HY_SLOW_PCT = 1.5
HY_IN = 3 * HY_WIDTH
Q_END = HY_IN + ATT_WIDTH
KV_W = N_KV_HEADS * HEAD_DIM
K_END = Q_END + KV_W
IN_EVEN = K_END + KV_W

CHUNK = 128
SG_WIDTH = D_MODEL
SG_GROUPS = 8
SG_GROUP_DIM = SG_WIDTH // SG_GROUPS

D_FF = 5632

kernel_name = 'hybrid_hyena_swa_gmlp_macaron'


def rmsnorm(x, g):
    xf = x.astype(jnp.float32)
    y = xf * lax.rsqrt(jnp.mean(xf * xf, axis=-1, keepdims=True) + EPS) * g.astype(jnp.float32)
    return y.astype(x.dtype)


def modulate(h, shift, scale):
    return h * (1 + scale) + shift


def swiglu(h, wg, wu, wd):
    return (jax.nn.silu(h @ wg) * (h @ wu)) @ wd


def half_ffn(x, g, shift, scale, gate, wg, wu, wd):
    return x + 0.5 * gate * swiglu(modulate(rmsnorm(x, g), shift, scale), wg, wu, wd)


def short_conv(z, w, b):
    L = z.shape[1]
    p = SHORT_CONV // 2
    zp = jnp.pad(z, ((0, 0), (p, p), (0, 0)))
    return sum(zp[:, j:j + L] * w[j] for j in range(SHORT_CONV)) + b


def hyena_filter(L, w1, b1, f1, w2, b2, f2, w3):
    f32 = jnp.float32
    t = jnp.linspace(0.0, 1.0, L, dtype=f32)[:, None]
    w = (2.0 * math.pi / L) * jnp.arange(L, dtype=f32)[:, None]
    bands = jnp.linspace(1e-4, HY_BANDS - 1, HY_BANDS, dtype=f32)[None, :]
    z = jnp.concatenate([t, jnp.cos(bands * w), -jnp.sin(bands * w)], axis=-1)
    h = jnp.sin(f1.astype(f32) * (z @ w1.astype(f32) + b1.astype(f32)))
    h = jnp.sin(f2.astype(f32) * (h @ w2.astype(f32) + b2.astype(f32)))
    h = (h @ w3.astype(f32)).reshape(L, 2, HY_WIDTH)
    lt = math.log(HY_DECAY_TARGET)
    deltas = jnp.abs(jnp.linspace(lt / HY_SLOW_PCT, lt / HY_FAST_PCT, HY_WIDTH, dtype=f32))
    h = h * jnp.exp(-t * deltas)[:, None, :]
    return h[:, 0], h[:, 1]


def bidir_long_conv(v, h_fwd, h_bwd, skip):
    B, L, C = v.shape
    k = jnp.concatenate([h_fwd, jnp.zeros((1, C), jnp.float32), h_bwd[:0:-1]], axis=0)
    k = k * lax.rsqrt(jnp.sum(k * k, axis=0, keepdims=True) + EPS)
    vf = v.astype(jnp.float32)
    y = jnp.fft.irfft(jnp.fft.rfft(vf, n=2 * L, axis=1) * jnp.fft.rfft(k, axis=0)[None], n=2 * L, axis=1)[:, :L]
    return (y + vf * skip.astype(jnp.float32)).astype(v.dtype)


def axial_rope(L):
    t = jnp.arange(L, dtype=jnp.int32)
    row = (t // GRID_W).astype(jnp.float32)
    col = (t % GRID_W).astype(jnp.float32)
    n = HEAD_DIM // 4
    inv = ROPE_BASE ** (-jnp.arange(n, dtype=jnp.float32) / n)
    ang = jnp.concatenate([row[:, None] * inv, col[:, None] * inv], axis=-1)
    return jnp.cos(ang), jnp.sin(ang)


def apply_rope(x, cos, sin):
    xf = x.astype(jnp.float32)
    half = HEAD_DIM // 2
    x1, x2 = xf[..., :half], xf[..., half:]
    c, s = cos[None, :, None, :], sin[None, :, None, :]
    return jnp.concatenate([x1 * c - x2 * s, x2 * c + x1 * s], axis=-1).astype(x.dtype)


def band(a):
    B, L = a.shape[:2]
    nb = L // ATT_BLOCK
    ap = jnp.pad(a, ((0, 0), (ATT_BLOCK, ATT_BLOCK), (0, 0), (0, 0))).reshape(B, nb + 2, ATT_BLOCK, *a.shape[2:])
    return jnp.concatenate([ap[:, :-2], ap[:, 1:-1], ap[:, 2:]], axis=2)


def window_attention(q, k, v, kc, vc, sink):
    B, L = q.shape[:2]
    nb = L // ATT_BLOCK
    f32 = jnp.float32
    scale = HEAD_DIM ** -0.5
    qb = q.reshape(B, nb, ATT_BLOCK, N_KV_HEADS, Q_PER_KV, HEAD_DIM)
    kb, vb = band(k), band(v)
    s_loc = jnp.einsum('bnqkgd,bnjkd->bnkgqj', qb, kb, preferred_element_type=f32) * scale
    s_ctx = jnp.einsum('bnqkgd,bckd->bnkgqc', qb, kc, preferred_element_type=f32) * scale
    off = jnp.arange(ATT_BLOCK)[:, None]
    cidx = jnp.arange(3 * ATT_BLOCK)[None, :]
    kpos = (jnp.arange(nb) * ATT_BLOCK - ATT_BLOCK)[:, None, None] + cidx[None]
    mask = (jnp.abs(cidx - ATT_BLOCK - off) <= WINDOW)[None] & (kpos >= 0) & (kpos < L)
    s_loc = jnp.where(mask[None, :, None, None], s_loc, NEG_INF)
    sink_l = jnp.broadcast_to(sink.astype(f32).reshape(N_KV_HEADS, Q_PER_KV, 1, 1), s_ctx.shape[:-1] + (1,))
    p = jax.nn.softmax(jnp.concatenate([sink_l, s_ctx, s_loc], axis=-1), axis=-1)
    n_ctx = kc.shape[1]
    p_ctx = p[..., 1:1 + n_ctx].astype(v.dtype)
    p_loc = p[..., 1 + n_ctx:].astype(v.dtype)
    o = (jnp.einsum('bnkgqc,bckd->bnqkgd', p_ctx, vc, preferred_element_type=f32)
         + jnp.einsum('bnkgqj,bnjkd->bnqkgd', p_loc, vb, preferred_element_type=f32))
    return o.reshape(B, L, ATT_WIDTH).astype(v.dtype)


def context_attention(qc, kc, vc, sink):
    B, C = qc.shape[:2]
    f32 = jnp.float32
    s = jnp.einsum('bqkgd,bckd->bkgqc', qc, kc, preferred_element_type=f32) * HEAD_DIM ** -0.5
    sink_l = jnp.broadcast_to(sink.astype(f32).reshape(N_KV_HEADS, Q_PER_KV, 1, 1), s.shape[:-1] + (1,))
    p = jax.nn.softmax(jnp.concatenate([sink_l, s], axis=-1), axis=-1)[..., 1:].astype(vc.dtype)
    o = jnp.einsum('bkgqc,bckd->bqkgd', p, vc, preferred_element_type=f32)
    return o.reshape(B, C, ATT_WIDTH).astype(vc.dtype)


def even_mixer(z, kc, vc, conv_w, conv_b, w1, b1, f1, w2, b2, f2, w3, skip, sink, latent):
    B, L, _ = z.shape
    hy = short_conv(z[..., :HY_IN], conv_w, conv_b)
    x0, x1, hv = hy[..., :HY_WIDTH], hy[..., HY_WIDTH:2 * HY_WIDTH], hy[..., 2 * HY_WIDTH:]
    h_fwd, h_bwd = hyena_filter(L, w1, b1, f1, w2, b2, f2, w3)
    y_hy = x0 * bidir_long_conv(hv * x1, h_fwd, h_bwd, skip)
    q = z[..., HY_IN:Q_END].reshape(B, L, N_Q_HEADS, HEAD_DIM)
    if latent:
        cos, sin = axial_rope(L)
        q = apply_rope(q, cos, sin).reshape(B, L, N_KV_HEADS, Q_PER_KV, HEAD_DIM)
        k = apply_rope(z[..., Q_END:K_END].reshape(B, L, N_KV_HEADS, HEAD_DIM), cos, sin)
        va = z[..., K_END:].reshape(B, L, N_KV_HEADS, HEAD_DIM)
        y_att = window_attention(q, k, va, kc, vc, sink)
    else:
        y_att = context_attention(q.reshape(B, L, N_KV_HEADS, Q_PER_KV, HEAD_DIM), kc, vc, sink)
    return jnp.concatenate([y_hy, y_att], axis=-1)


def spatial_gating(z, g, ws, bs):
    B, L, _ = z.shape
    z = jax.nn.gelu(z)
    u, v = z[..., :SG_WIDTH], rmsnorm(z[..., SG_WIDTH:], g)
    vr = v.reshape(B, L // CHUNK, CHUNK, SG_GROUPS, SG_GROUP_DIM)
    mixed = jnp.einsum('gpq,bnqgd->bnpgd', ws, vr) + bs.T[:, :, None]
    return u * mixed.reshape(B, L, SG_WIDTH)


def setup_inputs(seed: int = 0) -> dict:
    key = jax.random.key(seed)
    ks = jax.random.split(key, 32)
    f32 = jnp.float32
    D = D_MODEL

    def nrm(k, shape, s):
        return s * jax.random.normal(k, shape, f32)

    return {
        'x': nrm(ks[0], (BATCH, SEQ, D), 1.0),
        'c': nrm(ks[1], (BATCH, D), 1.0),
        'ctx': nrm(ks[2], (BATCH, CTX_LEN, D), 1.0),
        'c_ctx': nrm(ks[3], (D,), 1.0),
        'ada_w': nrm(ks[4], (DEPTH, D, N_MOD * D), 0.5 * D ** -0.5),
        'ada_b': nrm(ks[5], (DEPTH, N_MOD * D), 0.01),
        'norm_g': 1.0 + nrm(ks[6], (DEPTH, 3, D), 0.02),
        'ffn_wg': nrm(ks[7], (DEPTH, 2, D, D_FF), D ** -0.5),
        'ffn_wu': nrm(ks[8], (DEPTH, 2, D, D_FF), D ** -0.5),
        'ffn_wd': nrm(ks[9], (DEPTH, 2, D_FF, D), D_FF ** -0.5),
        'ev_w_in': nrm(ks[10], (N_EVEN, D, IN_EVEN), D ** -0.5),
        'ev_conv_w': nrm(ks[11], (N_EVEN, SHORT_CONV, HY_IN), SHORT_CONV ** -0.5),
        'ev_conv_b': nrm(ks[12], (N_EVEN, HY_IN), 0.01),
        'hy_w1': nrm(ks[13], (N_EVEN, HY_EMB, HY_FILTER_HIDDEN), HY_EMB ** -0.5),
        'hy_b1': nrm(ks[14], (N_EVEN, HY_FILTER_HIDDEN), 0.1),
        'hy_f1': 1.0 + nrm(ks[15], (N_EVEN, HY_FILTER_HIDDEN), 0.02),
        'hy_w2': nrm(ks[16], (N_EVEN, HY_FILTER_HIDDEN, HY_FILTER_HIDDEN), HY_FILTER_HIDDEN ** -0.5),
        'hy_b2': nrm(ks[17], (N_EVEN, HY_FILTER_HIDDEN), 0.1),
        'hy_f2': 1.0 + nrm(ks[18], (N_EVEN, HY_FILTER_HIDDEN), 0.02),
        'hy_w3': nrm(ks[19], (N_EVEN, HY_FILTER_HIDDEN, 2 * HY_WIDTH), HY_FILTER_HIDDEN ** -0.5),
        'hy_skip': nrm(ks[20], (N_EVEN, HY_WIDTH), 1.0),
        'att_sink': nrm(ks[21], (N_EVEN, N_Q_HEADS), 1.0),
        'ev_w_out': nrm(ks[22], (N_EVEN, D, D), D ** -0.5),
        'od_w_in': nrm(ks[23], (N_ODD, D, 2 * SG_WIDTH), D ** -0.5),
        'sg_g': 1.0 + nrm(ks[24], (N_ODD, SG_WIDTH), 0.02),
        'sg_ws': nrm(ks[25], (N_ODD, SG_GROUPS, CHUNK, CHUNK), CHUNK ** -0.5),
        'sg_bs': 1.0 + nrm(ks[26], (N_ODD, SG_GROUPS, CHUNK), 0.02),
        'od_w_out': nrm(ks[27], (N_ODD, SG_WIDTH, D), SG_WIDTH ** -0.5),
        'final_g': 1.0 + nrm(ks[28], (D,), 0.02),
    }


def reference(x, c, ctx, c_ctx, ada_w, ada_b, norm_g, ffn_wg, ffn_wu, ffn_wd,
              ev_w_in, ev_conv_w, ev_conv_b, hy_w1, hy_b1, hy_f1, hy_w2, hy_b2, hy_f2, hy_w3, hy_skip,
              att_sink, ev_w_out, od_w_in, sg_g, sg_ws, sg_bs, od_w_out, final_g):
    B = x.shape[0]
    s_lat = jax.nn.silu(c)
    s_ctx = jax.nn.silu(c_ctx)
    xc = ctx
    for layer in range(DEPTH):
        even = layer % 2 == 0
        li = layer // 2
        ctx_out = any(j % 2 == 0 for j in range(layer + 1, DEPTH))
        ctx_in = even or ctx_out
        mod = (s_lat @ ada_w[layer] + ada_b[layer]).reshape(B, N_MOD, 1, D_MODEL)
        mc = (s_ctx @ ada_w[layer] + ada_b[layer]).reshape(N_MOD, D_MODEL)
        g = norm_g[layer]
        wg, wu, wd = ffn_wg[layer], ffn_wu[layer], ffn_wd[layer]

        x = half_ffn(x, g[0], mod[:, 0], mod[:, 1], mod[:, 2], wg[0], wu[0], wd[0])
        if ctx_in:
            xc = half_ffn(xc, g[0], mc[0], mc[1], mc[2], wg[0], wu[0], wd[0])

        h = modulate(rmsnorm(x, g[1]), mod[:, 3], mod[:, 4])
        if even:
            w_in = ev_w_in[li]
            prm = (ev_conv_w[li], ev_conv_b[li], hy_w1[li], hy_b1[li], hy_f1[li], hy_w2[li], hy_b2[li],
                   hy_f2[li], hy_w3[li], hy_skip[li], att_sink[li])
            hc = modulate(rmsnorm(xc, g[1]), mc[3], mc[4])
            if ctx_out:
                zc = hc @ w_in
                kvc = zc[..., Q_END:]
            else:
                kvc = hc @ w_in[:, Q_END:]
            kc = kvc[..., :KV_W].reshape(B, -1, N_KV_HEADS, HEAD_DIM)
            vc = kvc[..., KV_W:].reshape(B, -1, N_KV_HEADS, HEAD_DIM)
            y = even_mixer(h @ w_in, kc, vc, *prm, latent=True) @ ev_w_out[li]
            if ctx_out:
                xc = xc + mc[5] * (even_mixer(zc, kc, vc, *prm, latent=False) @ ev_w_out[li])
        else:
            y = spatial_gating(h @ od_w_in[li], sg_g[li], sg_ws[li], sg_bs[li]) @ od_w_out[li]
            if ctx_out:
                hc = modulate(rmsnorm(xc, g[1]), mc[3], mc[4])
                xc = xc + mc[5] * (spatial_gating(hc @ od_w_in[li], sg_g[li], sg_ws[li], sg_bs[li]) @ od_w_out[li])
        x = x + mod[:, 5] * y

        x = half_ffn(x, g[2], mod[:, 6], mod[:, 7], mod[:, 8], wg[1], wu[1], wd[1])
        if ctx_out:
            xc = half_ffn(xc, g[2], mc[6], mc[7], mc[8], wg[1], wu[1], wd[1])
    return rmsnorm(x, final_g)
```

```cpp
#include <hip/hip_runtime.h>
#include <cstdio>
#include <cstdint>

#ifndef MK_PER_PHASE
#define MK_PER_PHASE 0
#endif

#define HD __host__ __device__ __forceinline__
#define DEV __device__ __forceinline__
#define LAS __attribute__((address_space(3)))
typedef unsigned short bf16;
typedef short bf16x8 __attribute__((ext_vector_type(8)));
typedef float f32x4 __attribute__((ext_vector_type(4)));
typedef float f32x2 __attribute__((ext_vector_type(2)));
typedef unsigned u32x4 __attribute__((ext_vector_type(4)));
typedef unsigned u32x2 __attribute__((ext_vector_type(2)));

constexpr int D = 2048, SEQ = 16384, NCTX = 256, MTOT = SEQ + NCTX, FF = 5632, NGU = 2 * FF;
constexpr int HYW = 1024, HYIN = 3072, INEV = 4608, NQK = 1280, NZT = 3328, ZTP = MTOT;
constexpr int NMOD = 9, NH = 8, HDIM = 128;
constexpr float EPS = 1e-6f;
constexpr int NTHR = 512;

constexpr size_t MiB = 1u << 20;
constexpr size_t WS_CTL = 0, CTL_ZERO_BYTES = 1 * MiB;
constexpr size_t WS_MOD = 1 * MiB;
constexpr size_t WS_ROPE = 1 * MiB + 512 * 1024;
constexpr size_t WS_SW = WS_CTL + 512 * 1024;
constexpr size_t WS_XC = 4 * MiB;
constexpr size_t WS_WGU = 8 * MiB;
constexpr size_t WGU_SZ = (size_t)NGU * D * 2;
constexpr size_t WS_WD = WS_WGU + 4 * WGU_SZ;
constexpr size_t WD_SZ = (size_t)D * FF * 2;
constexpr size_t WS_WIN = WS_WD + 4 * WD_SZ;
constexpr size_t WS_WOE = WS_WIN + (size_t)INEV * D * 2;
constexpr size_t WS_WODI = WS_WOE + (size_t)D * D * 2;
constexpr size_t WS_WODO = WS_WODI + (size_t)2 * D * D * 2;
constexpr size_t WS_XN = WS_WODO + (size_t)D * D * 2;
constexpr size_t WS_ACT = WS_XN + (size_t)MTOT * D * 2;
constexpr size_t ACT_SZ = (size_t)MTOT * FF * 2;
constexpr size_t WS_ZT = WS_ACT;
constexpr size_t WS_QK = WS_ACT + 106 * MiB;
constexpr size_t WS_U = WS_ACT;
constexpr size_t WS_VT = WS_ACT + 64 * MiB;
constexpr size_t WS_KT = (WS_ACT + ACT_SZ + MiB - 1) / MiB * MiB;
constexpr size_t WS_YHT = WS_KT;
constexpr size_t WS_YMIX = WS_KT + 32 * MiB;
constexpr int KSP = 8200;
constexpr size_t WS_KS = WS_KT + 128 * MiB;
constexpr size_t WS_WINC = 6 * MiB;
constexpr size_t WS_XB = WS_KS + 129 * MiB;
constexpr size_t WS_END = WS_XB + 64 * MiB;
static_assert(WS_ZT + (size_t)NZT * ZTP * 2 <= WS_QK && WS_QK + (size_t)MTOT * NQK * 2 <= WS_ACT + ACT_SZ, "overlay map");

constexpr int SW_IN0 = 0, SW_GU1 = INEV, SW_GU2 = INEV + NGU, SW_GU3 = INEV + 2 * NGU, SW_IN1 = INEV + 3 * NGU, SW_TOTAL = INEV + 3 * NGU + 2 * D;
constexpr size_t CTL_RS = 64 * 1024;
constexpr int LDS_BYTES = 160 * 1024 - 512;

DEV unsigned cvt_pk_bf16(float lo, float hi) { unsigned r; asm volatile("v_cvt_pk_bf16_f32 %0, %1, %2" : "=v"(r) : "v"(lo), "v"(hi)); return r; }
DEV float bf2f(unsigned short b) { return __uint_as_float(((unsigned)b) << 16); }
DEV float bflo(unsigned w) { return __uint_as_float(w << 16); }
DEV float bfhi(unsigned w) { return __uint_as_float(w & 0xffff0000u); }
DEV float wave_sum(float v) {
#pragma unroll
    for (int o = 32; o >= 1; o >>= 1) v += __shfl_xor(v, o);
    return v;
}
DEV float wave_max(float v) {
#pragma unroll
    for (int o = 32; o >= 1; o >>= 1) v = fmaxf(v, __shfl_xor(v, o));
    return v;
}
DEV f32x2 gelu_tanh_pk(f32x2 x) {
    f32x2 t = x * x; t = t * 0.044715f + 1.0f; t = t * x;
    const f32x2 a = t * (-2.88539008178f * 0.7978845608f);
    f32x2 e; e.x = __builtin_amdgcn_exp2f(a.x); e.y = __builtin_amdgcn_exp2f(a.y);
    const f32x2 d = e + 1.0f;
    f32x2 r; r.x = __builtin_amdgcn_rcpf(d.x); r.y = __builtin_amdgcn_rcpf(d.y);
    return x * r;
}
DEV unsigned swiglu_pk(f32x2 g, f32x2 u) {
    const f32x2 t = g * -1.44269504089f;
    f32x2 e; e.x = __builtin_amdgcn_exp2f(t.x); e.y = __builtin_amdgcn_exp2f(t.y);
    const f32x2 d = e + 1.0f;
    f32x2 r; r.x = __builtin_amdgcn_rcpf(d.x); r.y = __builtin_amdgcn_rcpf(d.y);
    const f32x2 o = (g * u) * r;
    return cvt_pk_bf16(o.x, o.y);
}
DEV float silu_f(float g) { return g * __builtin_amdgcn_rcpf(1.0f + __builtin_amdgcn_exp2f(-1.44269504089f * g)); }
DEV float gelu_tanh_f(float x) { const float u = 0.7978845608f * (x + 0.044715f * x * x * x); return x * __builtin_amdgcn_rcpf(1.0f + __builtin_amdgcn_exp2f(-2.88539008178f * u)); }

#define XB_TMO      128
#define XB_XCNT(j)  (256  + 64 * (j))
#define XB_XSUB(j)  (1280 + 64 * (j))
#define XB_XGEN(j)  (2304 + 64 * (j))
#define XB_TOP      3328
#define XB_TOPGEN   3392
#define XCD_BAR_WORDS 3456
#define XB_SPIN_CAP (1u << 18)

__device__ __forceinline__ unsigned xb_ld(unsigned* p)              { return __hip_atomic_load(p, __ATOMIC_RELAXED, __HIP_MEMORY_SCOPE_AGENT); }
__device__ __forceinline__ unsigned xb_add(unsigned* p, unsigned v) { return __hip_atomic_fetch_add(p, v, __ATOMIC_RELAXED, __HIP_MEMORY_SCOPE_AGENT); }
__device__ __forceinline__ unsigned xb_xcc_id() { return (unsigned)__builtin_amdgcn_s_getreg((3 << 11) | 20) & 0xFu; }
#define XB_SPIN(cond, bar) do { unsigned _sp = 0; while (cond) { __builtin_amdgcn_s_sleep(1); \
    if ((++_sp & 255u) == 0u) { if (xb_ld(&(bar)[XB_TMO])) break; if (_sp > XB_SPIN_CAP) { atomicAdd(&(bar)[XB_TMO], 1u); break; } } } } while (0)

struct XcdBarrier {
    unsigned* bar; unsigned x;
    volatile LAS unsigned* st;
};

__device__ __forceinline__ XcdBarrier xcd_barrier_post(unsigned* bar, volatile LAS unsigned* st) {
    XcdBarrier b; b.bar = bar; b.x = xb_xcc_id(); b.st = st;
    if (threadIdx.x == 0) (void)xb_add(&bar[XB_XCNT(b.x)], 1u);
    return b;
}
__device__ __forceinline__ void xcd_barrier_complete(unsigned* bar, unsigned x, unsigned& nloc, unsigned& nx) {
    const unsigned G = gridDim.x * gridDim.y * gridDim.z;
    unsigned sum, cnt, mine, sp = 0u;
    for (;;) {
        sum = 0u; cnt = 0u; mine = 0u;
#pragma unroll
        for (unsigned j = 0; j < 16; ++j) { const unsigned c = xb_ld(&bar[XB_XCNT(j)]); sum += c; cnt += (c > 0u) ? 1u : 0u; mine = (j == x) ? c : mine; }
        if (sum == G) break;
        __builtin_amdgcn_s_sleep(1);
        if ((++sp & 255u) == 0u) { if (xb_ld(&bar[XB_TMO])) break; if (sp > XB_SPIN_CAP) { atomicAdd(&bar[XB_TMO], 1u); break; } }
    }
    nloc = mine > 0u ? mine : 1u; nx = cnt > 0u ? cnt : 1u;
}

__device__ __forceinline__ void xcd_barrier(const XcdBarrier& b) {
    asm volatile("s_waitcnt vmcnt(0)" ::: "memory");
    __syncthreads();
    if (threadIdx.x == 0) {
        unsigned* bar = b.bar;
        __builtin_amdgcn_s_waitcnt(0);
        unsigned nloc = b.st[0], nx = b.st[1];
        if (nloc == 0u) { xcd_barrier_complete(bar, b.x, nloc, nx); b.st[0] = nloc; b.st[1] = nx; }
        const unsigned old = xb_add(&bar[XB_XSUB(b.x)], 1u);
        const unsigned gen = old / nloc;
        if (old + 1u == (gen + 1u) * nloc) {
            __builtin_amdgcn_fence(__ATOMIC_RELEASE, "agent");
            asm volatile("s_waitcnt vmcnt(0)" ::: "memory");
            const unsigned og = xb_add(&bar[XB_TOP], 1u);
            const unsigned tg = og / nx;
            if (og + 1u == (tg + 1u) * nx) xb_add(&bar[XB_TOPGEN], 1u);
            else XB_SPIN(xb_ld(&bar[XB_TOPGEN]) == tg, bar);
            __builtin_amdgcn_fence(__ATOMIC_ACQUIRE, "agent");
            xb_add(&bar[XB_XGEN(b.x)], 1u);
            asm volatile("s_waitcnt vmcnt(0)" ::: "memory");
        } else {
            XB_SPIN(xb_ld(&bar[XB_XGEN(b.x)]) == gen, bar);
            __builtin_amdgcn_fence(__ATOMIC_ACQUIRE, "agent");
            asm volatile("s_waitcnt vmcnt(0)" ::: "memory");
        }
    }
    __syncthreads();
}


namespace pg8 {
constexpr int BM = 256, BK = 64, HALF = 128, HTB = HALF * BK * 2, STAGE_BYTES = 8 * HTB, NXCD = 8, WGM = 8;
HD int lds_byte(int r, int c) { const int st = (r >> 4) * 2 + (c >> 5), rr = r & 15, cc = c & 31, ob = rr * 64 + cc * 2; return st * 1024 + (ob ^ (((ob >> 9) & 1) << 5)); }
HD void stage_rc(int b, int& R, int& C) { const int st = b / 1024, sb = b % 1024, swz = sb ^ (((sb >> 9) & 1) << 5); R = (st >> 1) * 16 + swz / 64; C = (st & 1) * 32 + (swz % 64) / 2; }
HD int perm32(int rho) { const int n = rho >> 4, i = rho & 15; return 8 * (i >> 2) + 4 * n + (i & 3); }
struct Unit { int pm, pn, ko, type; };
struct Gemm { const bf16* A; const bf16* Bt; int K, lda, ldb; const bf16* A2; const bf16* Bt2; };
struct StaticOrder {
    int nM, nN, nwg, G, c, nX, pmx, pnx0;
    HD void init(int nM_, int nN_, int G_, int c_, int nX_ = 0, int pmx_ = 0, int pnx0_ = 0) { nM = nM_; nN = nN_; nwg = nM * nN; G = G_; c = c_; nX = nX_; pmx = pmx_; pnx0 = pnx0_; }
    HD bool next(int i, Unit& u) const { return map((long)i * G + c, u); }
    HD bool map(long Lq, Unit& u) const {
        if (Lq >= nwg + nX) return false;
        u.ko = 0; u.type = 0; if (Lq >= nwg) { u.pm = pmx; u.pn = pnx0 + (int)(Lq - nwg); return true; }
        int wgid = (int)Lq; { const int q = nwg / NXCD, r = nwg % NXCD, xcd = wgid % NXCD, off = wgid / NXCD; wgid = (xcd < r ? xcd * (q + 1) : r * (q + 1) + (xcd - r) * q) + off; }
        const int nig = WGM * nN, gid = wgid / nig, fm = gid * WGM, gsz = (nM - fm) < WGM ? (nM - fm) : WGM;
        u.pm = fm + ((wgid % nig) % gsz); u.pn = (wgid % nig) / gsz; return true;
    }
    DEV void a_ready(const Unit&) const {}
    DEV void done(const Unit&) const {}
};
struct DualOrder {
    StaticOrder s0, s1; int n0, n1, G, c, nE, et0, epm0, epn0, et1, epm1, epn1;
    int dlo, dn;
    HD bool next(int i, Unit& u) const {
        long L = (long)i * G + c;
        if (L >= dlo && L < dlo + dn) return false;
        if (L >= n0 + n1 && L < n0 + n1 + dn) L = dlo + (L - n0 - n1);
        if (L < n0) { s0.map(L, u); u.type = 0; return true; }
        if (L < n0 + n1) { s1.map(L - n0, u); u.type = 1; return true; }
        const int e = (int)(L - n0 - n1 - dn); if (e < 0 || e >= nE) return false;
        u.ko = 0; u.type = e ? et1 : et0; u.pm = e ? epm1 : epm0; u.pn = e ? epn1 : epn0;
#if defined(__HIP_DEVICE_COMPILE__)
        u.type = __builtin_amdgcn_readfirstlane(u.type); u.pm = __builtin_amdgcn_readfirstlane(u.pm); u.pn = __builtin_amdgcn_readfirstlane(u.pn);
#endif
        return true;
    }
    DEV void a_ready(const Unit&) const {}
    DEV void done(const Unit&) const {}
};
template <class E0, class E1> struct EpiDual {
    static constexpr bool PERM = E0::PERM; static_assert(E0::PERM == E1::PERM, "EpiDual: both epilogues must stage B the same way");
    E0 e0; E1 e1;
    DEV void operator()(const f32x4 (&acc)[2][2][4][2], const Unit& u, int wr, int wc, int fr, int fq) const { if (u.type == 0) e0(acc, u, wr, wc, fr, fq); else e1(acc, u, wr, wc, fr, fq); }
};

template <class Epi, class Sched, bool ALIGN_EPI = true, bool SP2 = true>
DEV void gemm_phase(LAS unsigned char* lds, const Gemm g, const Sched& S, const Epi& E) {
    const int tid = threadIdx.x, wid = __builtin_amdgcn_readfirstlane(tid >> 6), lane = tid & 63, wr = wid >> 2, wc = wid & 3, fr = lane & 15, fq = lane >> 4;
    const int K = g.K, nt = K / BK;
    unsigned voffA[2], voffB[2];
#pragma unroll
    for (int i = 0; i < 2; ++i) { int R, C; stage_rc(tid * 16 + i * 8192, R, C); const int Rb = Epi::PERM ? ((R & ~31) + perm32(R & 31)) : R;
        voffA[i] = (unsigned)(R * g.lda + C) * 2u; voffB[i] = (unsigned)(Rb * g.ldb + C) * 2u; }
    const size_t kstep = (size_t)(BK * 2);
    const size_t hstepA = (size_t)HALF * g.lda * 2, hstepB = (size_t)HALF * g.ldb * 2;
    const size_t tstepA = 2 * hstepA, tstepB = 2 * hstepB;
    const unsigned ldsw = (unsigned)wid * 1024u;
    const int aoff = lds_byte(wr * 64 + fr, fq * 8), boff = lds_byte(wc * 32 + fr, fq * 8);
#define PG8_SA(b, h) (((b) * 2 + (h)) * HTB)
#define PG8_SB(b, h) ((4 + (b) * 2 + (h)) * HTB)
#define PG8_STAGE(bufoff, gbase, voff) do { _Pragma("unroll") for (int _i = 0; _i < 2; ++_i) \
        __builtin_amdgcn_global_load_lds((const unsigned*)((const char*)(gbase) + (voff)[_i]), (LAS unsigned*)(lds + (bufoff) + ldsw + _i * 8192), 16, 0, 0); } while (0)
#define PG8_LDA(dst, b, h) do { _Pragma("unroll") for (int m = 0; m < 4; ++m) _Pragma("unroll") for (int k = 0; k < 2; ++k) dst[m][k] = *(const LAS bf16x8*)(lds + PG8_SA(b, h) + aoff + m * 2048 + k * 1024); } while (0)
#define PG8_LDB(dst, b, h) do { _Pragma("unroll") for (int n = 0; n < 2; ++n) _Pragma("unroll") for (int k = 0; k < 2; ++k) dst[n][k] = *(const LAS bf16x8*)(lds + PG8_SB(b, h) + boff + n * 2048 + k * 1024); } while (0)
#define PG8_MMA(ai, bj, At, Bt) do { __builtin_amdgcn_s_setprio(1); _Pragma("unroll") for (int m = 0; m < 4; ++m) _Pragma("unroll") for (int n = 0; n < 2; ++n) _Pragma("unroll") for (int k = 0; k < 2; ++k) \
        acc[ai][bj][m][n] = __builtin_amdgcn_mfma_f32_16x16x32_bf16(Bt[n][k], At[m][k], acc[ai][bj][m][n], 0, 0, 0); __builtin_amdgcn_s_setprio(0); } while (0)
#define PG8_WAIT_V(n) asm volatile("s_waitcnt vmcnt(" #n ")" ::: "memory")
#define PG8_WAIT_L(n) asm volatile("s_waitcnt lgkmcnt(" #n ")" ::: "memory")
#define PG8_BAR __builtin_amdgcn_s_barrier()
#define PG8_SCHED __builtin_amdgcn_sched_barrier(0)
    Unit cur, nxt; int ui = 0;
    if (!S.next(0, cur)) return;
    f32x4 acc[2][2][4][2];
#pragma unroll
    for (int a = 0; a < 2; ++a)
#pragma unroll
        for (int b = 0; b < 2; ++b)
#pragma unroll
            for (int m = 0; m < 4; ++m)
#pragma unroll
                for (int n = 0; n < 2; ++n) acc[a][b][m][n] = (f32x4){0.f, 0.f, 0.f, 0.f};
    bf16x8 At[4][2], B0[2][2], B1[2][2];
    const char* cA = (const char*)(cur.type ? g.A2 : g.A) + (size_t)cur.pm * tstepA + (size_t)cur.ko * 2; const char* cB = (const char*)(cur.type ? g.Bt2 : g.Bt) + (size_t)cur.pn * tstepB + (size_t)cur.ko * 2;
    S.a_ready(cur);
    if constexpr (SP2) {
        PG8_STAGE(PG8_SB(0, 0), cB, voffB); PG8_STAGE(PG8_SB(0, 1), cB + hstepB, voffB); PG8_STAGE(PG8_SA(0, 0), cA, voffA); PG8_STAGE(PG8_SA(0, 1), cA + hstepA, voffA);
        if (wr == 1) PG8_BAR;
        PG8_WAIT_V(2); PG8_BAR;
        PG8_STAGE(PG8_SB(1, 0), cB + kstep, voffB); PG8_STAGE(PG8_SA(1, 0), cA + kstep, voffA); PG8_STAGE(PG8_SB(1, 1), cB + hstepB + kstep, voffB);
        PG8_WAIT_V(6); PG8_BAR;
    }
    for (;;) {
        const bool has_next = S.next(ui + 1, nxt);
        const char* nA = has_next ? (const char*)(nxt.type ? g.A2 : g.A) + (size_t)nxt.pm * tstepA + (size_t)nxt.ko * 2 : cA; const char* nB = has_next ? (const char*)(nxt.type ? g.Bt2 : g.Bt) + (size_t)nxt.pn * tstepB + (size_t)nxt.ko * 2 : cB;
        for (int t = 0; t < nt; t += 2) {
            const bool last = (t == nt - 2);
            const char* a1 = cA + (size_t)(t + 1) * kstep;
            const char* a2 = last ? nA : cA + (size_t)(t + 2) * kstep; const char* b2 = last ? nB : cB + (size_t)(t + 2) * kstep;
            const char* a3 = a2 + kstep; const char* b3 = b2 + kstep;
            if (last && has_next) S.a_ready(nxt);
            if constexpr (SP2) {
            PG8_LDB(B0, 0, 0); PG8_LDB(B1, 0, 1); PG8_SCHED; PG8_LDA(At, 0, 0); PG8_STAGE(PG8_SA(1, 1), a1 + hstepA, voffA);
            PG8_WAIT_V(8); PG8_WAIT_L(0); PG8_BAR; PG8_MMA(0, 0, At, B0); PG8_MMA(0, 1, At, B1); PG8_BAR; PG8_SCHED;
            PG8_LDA(At, 0, 1); PG8_STAGE(PG8_SB(0, 0), b2, voffB); PG8_STAGE(PG8_SB(0, 1), b2 + hstepB, voffB); PG8_STAGE(PG8_SA(0, 0), a2, voffA);
            PG8_WAIT_V(8); PG8_WAIT_L(0); PG8_BAR; PG8_MMA(1, 0, At, B0); PG8_MMA(1, 1, At, B1); PG8_BAR; PG8_SCHED;
            PG8_LDB(B0, 1, 0); PG8_LDB(B1, 1, 1); PG8_SCHED; PG8_LDA(At, 1, 0); PG8_STAGE(PG8_SA(0, 1), a2 + hstepA, voffA);
            PG8_WAIT_V(8); PG8_WAIT_L(0); PG8_BAR; PG8_MMA(0, 0, At, B0); PG8_MMA(0, 1, At, B1); PG8_BAR; PG8_SCHED;
            PG8_LDA(At, 1, 1); PG8_STAGE(PG8_SB(1, 0), b3, voffB); PG8_STAGE(PG8_SB(1, 1), b3 + hstepB, voffB); PG8_STAGE(PG8_SA(1, 0), a3, voffA);
            PG8_WAIT_V(8); PG8_WAIT_L(0); PG8_BAR; PG8_MMA(1, 0, At, B0); PG8_MMA(1, 1, At, B1); PG8_BAR; PG8_SCHED;
            }
        }
        if constexpr (ALIGN_EPI) { if (wr == 0) PG8_BAR; }
        E(acc, cur, wr, wc, fr, fq); S.done(cur);
        if (!has_next) break;
#pragma unroll
        for (int a = 0; a < 2; ++a)
#pragma unroll
            for (int b = 0; b < 2; ++b)
#pragma unroll
                for (int m = 0; m < 4; ++m)
#pragma unroll
                    for (int n = 0; n < 2; ++n) acc[a][b][m][n] = (f32x4){0.f, 0.f, 0.f, 0.f};
        cur = nxt; cA = nA; cB = nB; ++ui;
        if constexpr (ALIGN_EPI) { if (wr == 1) PG8_BAR; }
    }
    PG8_WAIT_V(0);
    if constexpr (!ALIGN_EPI) { if (wr == 0) PG8_BAR; }
    PG8_BAR;
#undef PG8_SA
#undef PG8_SB
#undef PG8_STAGE
#undef PG8_LDA
#undef PG8_LDB
#undef PG8_MMA
#undef PG8_WAIT_V
#undef PG8_WAIT_L
#undef PG8_BAR
#undef PG8_SCHED
}
}
using pg8::Unit;
typedef f32x4 Acc[2][2][4][2];

DEV float rsq_f(float ss) { return __builtin_amdgcn_rsqf(ss * (1.0f / D) + EPS); }
DEV float rstd_of(const float* rs, int row) { return rsq_f(rs[row]); }
constexpr int LDS_RT = 131072, LDS_SWT = 131072 + 8192;
DEV void stage_gateup_tables(const float* rs, const float* sw, int rowbase, LAS unsigned char* lds, int tid) {
    LAS float* rt = (LAS float*)(lds + LDS_RT); LAS unsigned* swt = (LAS unsigned*)(lds + LDS_SWT);
    for (int i = tid; i < 2048; i += NTHR) rt[i] = 1.0f / sqrtf(rs[rowbase + i] * (1.0f / D) + EPS);
    for (int i = tid; i < NGU / 2; i += NTHR) { const f32x2 v = *(const f32x2*)(sw + 2 * i); swt[i] = cvt_pk_bf16(v.x, v.y); }
    __syncthreads();
}
template <bool SCALE> struct EpiSwiGLU {
    static constexpr bool PERM = true;
    bf16* O; int ldc; LAS unsigned char* lds; int rowbase;
    DEV void operator()(const Acc& acc, const Unit& u, int wr, int wc, int fr, int fq) const {
        const int row0 = u.pm * 256 + wr * 64 + fr, cl = wc * 32 + 8 * fq, col0 = u.pn * 128 + cl;
        f32x4 sg0 = (f32x4){0.f, 0.f, 0.f, 0.f}, sg1 = sg0, su0 = sg0, su1 = sg0;
        if (SCALE) {
            const u32x4 gw = *(const LAS u32x4*)(lds + LDS_SWT + (u.pn * 256 + cl) * 2), uw = *(const LAS u32x4*)(lds + LDS_SWT + (u.pn * 256 + 128 + cl) * 2);
            sg0 = (f32x4){bflo(gw.x), bfhi(gw.x), bflo(gw.y), bfhi(gw.y)}; sg1 = (f32x4){bflo(gw.z), bfhi(gw.z), bflo(gw.w), bfhi(gw.w)};
            su0 = (f32x4){bflo(uw.x), bfhi(uw.x), bflo(uw.y), bfhi(uw.y)}; su1 = (f32x4){bflo(uw.z), bfhi(uw.z), bflo(uw.w), bfhi(uw.w)};
        }
        const LAS float* rt = (const LAS float*)(lds + LDS_RT) + (row0 - rowbase);
#pragma unroll
        for (int ai = 0; ai < 2; ++ai)
#pragma unroll
            for (int m = 0; m < 4; ++m) {
                const int row = row0 + ai * 128 + m * 16;
                bf16* rowp = O + (size_t)row * ldc + col0;
                const float r = SCALE ? rt[ai * 128 + m * 16] : 1.0f;
                const f32x4 g0 = acc[ai][0][m][0] * r + sg0, g1 = acc[ai][0][m][1] * r + sg1, u0 = acc[ai][1][m][0] * r + su0, u1 = acc[ai][1][m][1] * r + su1;
                u32x4 w;
                w.x = swiglu_pk((f32x2){g0[0], g0[1]}, (f32x2){u0[0], u0[1]}); w.y = swiglu_pk((f32x2){g0[2], g0[3]}, (f32x2){u0[2], u0[3]});
                w.z = swiglu_pk((f32x2){g1[0], g1[1]}, (f32x2){u1[0], u1[1]}); w.w = swiglu_pk((f32x2){g1[2], g1[3]}, (f32x2){u1[2], u1[3]});
                *(u32x4*)rowp = w;
            }
    }
};
template <bool FUSE, bool HALFC, bool BASEF32> struct EpiRes {
    static constexpr bool PERM = true;
    static constexpr float cmul = HALFC ? 0.5f : 1.0f;
    static constexpr int PF = BASEF32 ? 2 : 3;
    const void* base; bf16* out; const float* coef; float* rs;
    struct Row { u32x4 w[BASEF32 ? 2 : 1]; };
    DEV Row ldr(size_t off) const {
        Row r;
        if (BASEF32) { r.w[0] = *(const u32x4*)((const float*)base + off); r.w[BASEF32 ? 1 : 0] = *(const u32x4*)((const float*)base + off + 4); }
        else r.w[0] = *(const u32x4*)((const bf16*)base + off);
        return r;
    }
    DEV void unpack(const Row& r, f32x4& lo, f32x4& hi) const {
        if (BASEF32) { const u32x4 a = r.w[0], b = r.w[BASEF32 ? 1 : 0]; lo = (f32x4){__uint_as_float(a.x), __uint_as_float(a.y), __uint_as_float(a.z), __uint_as_float(a.w)}; hi = (f32x4){__uint_as_float(b.x), __uint_as_float(b.y), __uint_as_float(b.z), __uint_as_float(b.w)}; }
        else { const u32x4 w = r.w[0]; lo = (f32x4){bflo(w.x), bfhi(w.x), bflo(w.y), bfhi(w.y)}; hi = (f32x4){bflo(w.z), bfhi(w.z), bflo(w.w), bfhi(w.w)}; }
    }
    DEV void operator()(const Acc& acc, const Unit& u, int wr, int wc, int fr, int fq) const {
        const int row0 = u.pm * 256 + wr * 64 + fr, col0 = u.pn * 256 + wc * 32 + 8 * fq;
        f32x4 cv[2][2];
#pragma unroll
        for (int bj = 0; bj < 2; ++bj)
#pragma unroll
            for (int n = 0; n < 2; ++n) cv[bj][n] = *(const f32x4*)(coef + col0 + bj * 128 + 4 * n) * cmul;
        Row ring[PF][2];
#pragma unroll
        for (int gp = 0; gp < PF; ++gp)
#pragma unroll
            for (int bj = 0; bj < 2; ++bj) ring[gp][bj] = ldr((size_t)(row0 + (gp >> 2) * 128 + (gp & 3) * 16) * D + col0 + bj * 128);
#pragma unroll
        for (int gi = 0; gi < 8; ++gi) {
            const int ai = gi >> 2, m = gi & 3;
            const int row = row0 + ai * 128 + m * 16;
            const size_t off = (size_t)row * D + col0;
            float ss = 0.f;
#pragma unroll
            for (int bj = 0; bj < 2; ++bj) {
                f32x4 b0, b1; unpack(ring[gi % PF][bj], b0, b1);
                const f32x4 o0 = b0 + cv[bj][0] * acc[ai][bj][m][0], o1 = b1 + cv[bj][1] * acc[ai][bj][m][1];
                u32x4 xo; xo.x = cvt_pk_bf16(o0[0], o0[1]); xo.y = cvt_pk_bf16(o0[2], o0[3]); xo.z = cvt_pk_bf16(o1[0], o1[1]); xo.w = cvt_pk_bf16(o1[2], o1[3]);
                *(u32x4*)(out + off + bj * 128) = xo;
                if (FUSE) {
                    const float q0 = bflo(xo.x), q1 = bfhi(xo.x), q2 = bflo(xo.y), q3 = bfhi(xo.y), q4 = bflo(xo.z), q5 = bfhi(xo.z), q6 = bflo(xo.w), q7 = bfhi(xo.w);
                    ss += (q0 * q0 + q1 * q1) + (q2 * q2 + q3 * q3) + (q4 * q4 + q5 * q5) + (q6 * q6 + q7 * q7); }
            }
            if (FUSE) { ss += __shfl_xor(ss, 16); ss += __shfl_xor(ss, 32); if (fq == 0) atomicAdd(rs + row, ss); }
            if (gi + PF < 8) { const int rown = row0 + ((gi + PF) >> 2) * 128 + ((gi + PF) & 3) * 16;
#pragma unroll
                for (int bj = 0; bj < 2; ++bj) ring[gi % PF][bj] = ldr((size_t)rown * D + col0 + bj * 128); }
        }
    }
};
struct EpiResAtomic {
    static constexpr bool PERM = false;
    float* out; const float* coef; float cmul;
    DEV void operator()(const Acc& acc, const Unit& u, int wr, int wc, int fr, int fq) const {
        const int row0 = wr * 64 + fr, col0 = u.pn * 256 + wc * 32 + 4 * fq;
#pragma unroll
        for (int bj = 0; bj < 2; ++bj)
#pragma unroll
            for (int n = 0; n < 2; ++n) {
                const f32x4 cv = *(const f32x4*)(coef + col0 + bj * 128 + n * 16) * cmul;
#pragma unroll
                for (int ai = 0; ai < 2; ++ai)
#pragma unroll
                    for (int m = 0; m < 4; ++m) { float* p = out + (size_t)(row0 + ai * 128 + m * 16) * D + col0 + bj * 128 + n * 16; const f32x4 v = cv * acc[ai][bj][m][n];
#pragma unroll
                        for (int j = 0; j < 4; ++j) atomicAdd(p + j, v[j]); }
            }
    }
};
struct SplitOrder {
    int G, c;
    HD bool next(int i, Unit& u) const { const int idx = i * G + c; if (idx >= 32) return false; u.pm = 64; u.pn = idx >> 2; u.ko = (idx & 3) * (FF / 4); u.type = 0; return true; }
    DEV void a_ready(const Unit&) const {}
    DEV void done(const Unit&) const {}
};
struct EpiGeluUV {
    static constexpr bool PERM = true;
    bf16* U; bf16* V; const float* rs; const float* sw; float* rsv;
    DEV void operator()(const Acc& acc, const Unit& u, int wr, int wc, int fr, int fq) const {
        const int row0 = u.pm * 256 + wr * 64 + fr, col0 = u.pn * 256 + wc * 32 + 8 * fq;
        const bool isv = u.pn >= 8;
        bf16* O = isv ? V + (col0 - D) : U + col0;
        f32x4 s0[2], s1[2];
#pragma unroll
        for (int bj = 0; bj < 2; ++bj) { s0[bj] = *(const f32x4*)(sw + col0 + bj * 128); s1[bj] = *(const f32x4*)(sw + col0 + bj * 128 + 4); }
        float rv[2][4];
#pragma unroll
        for (int ai = 0; ai < 2; ++ai)
#pragma unroll
            for (int m = 0; m < 4; ++m) rv[ai][m] = rs[row0 + ai * 128 + m * 16];
#pragma unroll
        for (int ai = 0; ai < 2; ++ai)
#pragma unroll
            for (int m = 0; m < 4; ++m) {
                const int row = row0 + ai * 128 + m * 16;
                const float r = rsq_f(rv[ai][m]);
                float ss = 0.f;
#pragma unroll
                for (int bj = 0; bj < 2; ++bj) {
                    f32x4 v0 = acc[ai][bj][m][0] * r + s0[bj], v1 = acc[ai][bj][m][1] * r + s1[bj];
#pragma unroll
                    for (int j = 0; j < 4; j += 2) { const f32x2 a0 = gelu_tanh_pk((f32x2){v0[j], v0[j + 1]}), a1 = gelu_tanh_pk((f32x2){v1[j], v1[j + 1]});
                        v0[j] = a0.x; v0[j + 1] = a0.y; v1[j] = a1.x; v1[j + 1] = a1.y; const f32x2 q = a0 * a0 + a1 * a1; ss += q.x + q.y; }
                    u32x4 w; w.x = cvt_pk_bf16(v0[0], v0[1]); w.y = cvt_pk_bf16(v0[2], v0[3]); w.z = cvt_pk_bf16(v1[0], v1[1]); w.w = cvt_pk_bf16(v1[2], v1[3]);
                    *(u32x4*)(O + (size_t)row * D + bj * 128) = w;
                }
                if (isv) { ss += __shfl_xor(ss, 16); ss += __shfl_xor(ss, 32); if (fq == 0) atomicAdd(rsv + row, ss); }
            }
    }
};
template <bool GELU_SS> struct EpiT {
    static constexpr bool PERM = true;
    bf16* O; int ldc; const float* rs; const float* sw; float* SS;
    DEV void operator()(const Acc& acc, const Unit& u, int wr, int wc, int fr, int fq) const {
        const int row0 = u.pm * 256 + wr * 64 + fr, col0 = u.pn * 256 + wc * 32 + 8 * fq;
        const bool sc = u.pn < 64;
        float shv[2][4];
#pragma unroll
        for (int ai = 0; ai < 2; ++ai)
#pragma unroll
            for (int m = 0; m < 4; ++m) shv[ai][m] = sc ? sw[row0 + ai * 128 + m * 16] : 0.0f;
#pragma unroll
        for (int bj = 0; bj < 2; ++bj) {
            f32x4 r0 = (f32x4){1.f, 1.f, 1.f, 1.f}, r1 = r0;
            if (sc) { const f32x4 a0 = *(const f32x4*)(rs + col0 + bj * 128), a1 = *(const f32x4*)(rs + col0 + bj * 128 + 4);
#pragma unroll
                for (int j = 0; j < 4; ++j) { r0[j] = rsq_f(a0[j]); r1[j] = rsq_f(a1[j]); } }
            float ss[8];
#pragma unroll
            for (int j = 0; j < 8; ++j) ss[j] = 0.f;
#pragma unroll
            for (int ai = 0; ai < 2; ++ai)
#pragma unroll
                for (int m = 0; m < 4; ++m) {
                    const int row = row0 + ai * 128 + m * 16;
                    const float sh = shv[ai][m];
                    f32x4 v0 = acc[ai][bj][m][0] * r0 + sh, v1 = acc[ai][bj][m][1] * r1 + sh;
                    if (GELU_SS) {
#pragma unroll
                        for (int j = 0; j < 4; ++j) { v0[j] = gelu_tanh_f(v0[j]); v1[j] = gelu_tanh_f(v1[j]); ss[j] += v0[j] * v0[j]; ss[4 + j] += v1[j] * v1[j]; } }
                    u32x4 w; w.x = cvt_pk_bf16(v0[0], v0[1]); w.y = cvt_pk_bf16(v0[2], v0[3]); w.z = cvt_pk_bf16(v1[0], v1[1]); w.w = cvt_pk_bf16(v1[2], v1[3]);
                    *(u32x4*)(O + (size_t)row * ldc + col0 + bj * 128) = w;
                }
            if (GELU_SS) {
#pragma unroll
                for (int j = 0; j < 8; ++j) { float t = ss[j]; t += __shfl_xor(t, 1); t += __shfl_xor(t, 2); t += __shfl_xor(t, 4); t += __shfl_xor(t, 8); ss[j] = t; }
                if (fr == 0) { float* dst = SS + (size_t)(u.pm * 2 + wr) * SEQ + col0 + bj * 128; *(f32x4*)dst = (f32x4){ss[0], ss[1], ss[2], ss[3]}; *(f32x4*)(dst + 4) = (f32x4){ss[4], ss[5], ss[6], ss[7]}; }
            }
        }
    }
};
struct EpiQKV {
    static constexpr bool PERM = true;
    bf16* O; const f32x2* rope; const float* rs; const float* sw;
    DEV void operator()(const Acc& acc, const Unit& u, int wr, int wc, int fr, int fq) const {
        const int row0 = u.pm * 256 + wr * 64 + fr, col0 = u.pn * 256 + wc * 32 + 8 * fq;
        const bool lat = (u.pm < 64);
        f32x4 s0[2], s1[2];
#pragma unroll
        for (int bj = 0; bj < 2; ++bj) { s0[bj] = lat ? *(const f32x4*)(sw + col0 + bj * 128) : (f32x4){0.f, 0.f, 0.f, 0.f}; s1[bj] = lat ? *(const f32x4*)(sw + col0 + bj * 128 + 4) : (f32x4){0.f, 0.f, 0.f, 0.f}; }
        float rv[2][4];
#pragma unroll
        for (int ai = 0; ai < 2; ++ai)
#pragma unroll
            for (int m = 0; m < 4; ++m) rv[ai][m] = lat ? rs[row0 + ai * 128 + m * 16] : 0.0f;
#pragma unroll
        for (int ai = 0; ai < 2; ++ai)
#pragma unroll
            for (int m = 0; m < 4; ++m) {
                const int row = row0 + ai * 128 + m * 16;
                bf16* rowp = O + (size_t)row * NQK + col0;
                const float r = lat ? rsq_f(rv[ai][m]) : 1.0f;
                f32x4 cA[2], cB[2];
#pragma unroll
                for (int bj = 0; bj < 2; ++bj) {
                    const int j0 = ((col0 + bj * 128) & 127) >> 1;
                    const int pos = (j0 < 32) ? (row >> 6) : (row & 63); const int f0 = j0 & 31;
                    const f32x4* rp4 = (const f32x4*)(rope + (lat ? pos * 32 + f0 : 0));
                    cA[bj] = rp4[0]; cB[bj] = rp4[1];
                }
#pragma unroll
                for (int bj = 0; bj < 2; ++bj) {
                    f32x4 v0 = acc[ai][bj][m][0] * r + s0[bj], v1 = acc[ai][bj][m][1] * r + s1[bj];
                    if (lat) {
                        const f32x2 c0 = (f32x2){cA[bj][0], cA[bj][1]}, c1 = (f32x2){cA[bj][2], cA[bj][3]}, c2 = (f32x2){cB[bj][0], cB[bj][1]}, c3 = (f32x2){cB[bj][2], cB[bj][3]};
                        f32x4 q0, q1;
                        q0[0] = v0[0] * c0.x - v0[1] * c0.y; q0[1] = v0[1] * c0.x + v0[0] * c0.y;
                        q0[2] = v0[2] * c1.x - v0[3] * c1.y; q0[3] = v0[3] * c1.x + v0[2] * c1.y;
                        q1[0] = v1[0] * c2.x - v1[1] * c2.y; q1[1] = v1[1] * c2.x + v1[0] * c2.y;
                        q1[2] = v1[2] * c3.x - v1[3] * c3.y; q1[3] = v1[3] * c3.x + v1[2] * c3.y;
                        v0 = q0; v1 = q1;
                    }
                    u32x4 w; w.x = cvt_pk_bf16(v0[0], v0[1]); w.y = cvt_pk_bf16(v0[2], v0[3]); w.z = cvt_pk_bf16(v1[0], v1[1]); w.w = cvt_pk_bf16(v1[2], v1[3]);
                    *(u32x4*)(rowp + bj * 128) = w;
                }
            }
    }
};

constexpr int FN = 16384;
HD f32x2 mk2(float a, float b) { f32x2 r; r.x = a; r.y = b; return r; }
HD f32x2 cmulf(f32x2 a, f32x2 b) { const f32x2 t = b * mk2(a.x, a.x); return __builtin_elementwise_fma(mk2(-b.y, b.x), mk2(a.y, a.y), t); }
HD f32x2 cmulcf(f32x2 a, f32x2 b) { const f32x2 t = a * mk2(b.x, b.x); return __builtin_elementwise_fma(mk2(a.y, -a.x), mk2(b.y, b.y), t); }
HD int drev4(int f) {
#if defined(__HIP_DEVICE_COMPILE__)
    unsigned r = __brev((unsigned)f) >> 18;
#else
    unsigned r = 0; for (int i = 0; i < 14; ++i) r |= (((unsigned)f >> i) & 1u) << (13 - i);
#endif
    return (int)(((r & 0x1555u) << 1) | ((r >> 1) & 0x1555u));
}
HD int fpad(int e) { return e + (e >> 4); }
constexpr int FBUF = FN + FN / 16;
template <class TT> HD f32x2 twid(TT T1, TT T2, int m) { return cmulf(T1[m >> 6], T2[m & 63]); }
HD void bfly4(f32x2& a, f32x2& b, f32x2& c, f32x2& d, bool inv) {
    const f32x2 t0 = a + c, t1 = a - c, t2 = b + d, dd = b - d;
    const f32x2 t3 = inv ? mk2(-dd.y, dd.x) : mk2(dd.y, -dd.x);
    a = t0 + t2; b = t1 + t3; c = t0 - t2; d = t1 - t3;
}
template <bool INV, bool HALF = false, class P2, class TT>
HD void fft_pass4(P2 buf, int tid, int nthr, TT T1, TT T2) {
    constexpr int qs = FN / 4;
    const int ou = nthr + (nthr >> 4), oq = qs + (qs >> 4);
    for (int j0 = tid; j0 < qs; j0 += 4 * nthr) {
        const int pb = fpad(j0);
        f32x2 e[4][4];
#pragma unroll
        for (int u = 0; u < 4; ++u)
#pragma unroll
            for (int r = 0; r < ((HALF && !INV) ? 2 : 4); ++r) e[u][r] = buf[pb + u * ou + r * oq];
#pragma unroll
        for (int u = 0; u < 4; ++u) {
            const f32x2 w1 = twid(T1, T2, j0 + u * nthr), w2 = cmulf(w1, w1), w3 = cmulf(w2, w1);
            if (INV) { e[u][1] = cmulcf(e[u][1], w1); e[u][2] = cmulcf(e[u][2], w2); e[u][3] = cmulcf(e[u][3], w3); }
            if (HALF && !INV) {
                const f32x2 xa = e[u][0], xb = e[u][1], t3 = mk2(xb.y, -xb.x);
                e[u][0] = xa + xb; e[u][1] = xa + t3; e[u][2] = xa - xb; e[u][3] = xa - t3;
            } else if (HALF && INV) {
                const f32x2 t0 = e[u][0] + e[u][2], t1 = e[u][0] - e[u][2], t2 = e[u][1] + e[u][3], dd = e[u][1] - e[u][3];
                e[u][0] = t0 + t2; e[u][1] = t1 + mk2(-dd.y, dd.x);
            } else bfly4(e[u][0], e[u][1], e[u][2], e[u][3], INV);
            if (!INV) { e[u][1] = cmulf(e[u][1], w1); e[u][2] = cmulf(e[u][2], w2); e[u][3] = cmulf(e[u][3], w3); }
        }
#pragma unroll
        for (int u = 0; u < 4; ++u)
#pragma unroll
            for (int r = 0; r < ((HALF && INV) ? 2 : 4); ++r) buf[pb + u * ou + r * oq] = e[u][r];
    }
}
template <bool INV, class P2, class TT>
HD void fft_pass16(P2 buf, int s, int tid, int nthr, TT T1, TT T2) {
    const int shs = 14 - 2 * s, lq1 = shs - 4, q1 = 1 << lq1, qs = q1 << 2;
    constexpr float CR[10] = {1.0f, 0.9238795325112867f, 0.7071067811865476f, 0.3826834323650898f, 0.0f, -0.3826834323650898f, -0.7071067811865476f, -0.9238795325112867f, -1.0f, -0.9238795325112867f};
    constexpr float CI[10] = {0.0f, -0.3826834323650898f, -0.7071067811865476f, -0.9238795325112867f, -1.0f, -0.9238795325112867f, -0.7071067811865476f, -0.3826834323650898f, 0.0f, 0.3826834323650898f};
    const int o1 = (lq1 >= 4) ? q1 + (q1 >> 4) : q1, os = (lq1 >= 4) ? qs + (qs >> 4) : qs;
    for (int b0 = tid; b0 < FN / 16; b0 += 2 * nthr) {
        f32x2 x[2][4][4]; int base[2], jpv[2];
#pragma unroll
        for (int it = 0; it < 2; ++it) {
            const int b = b0 + it * nthr, grp = b >> lq1; jpv[it] = b & (q1 - 1); base[it] = fpad((grp << shs) + jpv[it]);
#pragma unroll
            for (int r1 = 0; r1 < 4; ++r1)
#pragma unroll
                for (int r2 = 0; r2 < 4; ++r2) x[it][r1][r2] = buf[base[it] + r1 * os + r2 * o1];
        }
#pragma unroll
        for (int it = 0; it < 2; ++it) {
            const f32x2 Wb = twid(T1, T2, jpv[it] << (2 * s));
            const f32x2 Wb2 = cmulf(Wb, Wb), Wb3 = cmulf(Wb2, Wb), Wb4 = cmulf(Wb2, Wb2), Wb8 = cmulf(Wb4, Wb4), Wb12 = cmulf(Wb8, Wb4);
            if (!INV) {
#pragma unroll
                for (int r2 = 0; r2 < 4; ++r2) {
                    bfly4(x[it][0][r2], x[it][1][r2], x[it][2][r2], x[it][3][r2], false);
                    x[it][1][r2] = cmulf(x[it][1][r2], cmulf(Wb, mk2(CR[r2], CI[r2])));
                    x[it][2][r2] = cmulf(x[it][2][r2], cmulf(Wb2, mk2(CR[2 * r2], CI[2 * r2])));
                    x[it][3][r2] = cmulf(x[it][3][r2], cmulf(Wb3, mk2(CR[3 * r2], CI[3 * r2])));
                }
#pragma unroll
                for (int r1 = 0; r1 < 4; ++r1) {
                    bfly4(x[it][r1][0], x[it][r1][1], x[it][r1][2], x[it][r1][3], false);
                    x[it][r1][1] = cmulf(x[it][r1][1], Wb4); x[it][r1][2] = cmulf(x[it][r1][2], Wb8); x[it][r1][3] = cmulf(x[it][r1][3], Wb12);
                }
            } else {
#pragma unroll
                for (int r1 = 0; r1 < 4; ++r1) {
                    x[it][r1][1] = cmulcf(x[it][r1][1], Wb4); x[it][r1][2] = cmulcf(x[it][r1][2], Wb8); x[it][r1][3] = cmulcf(x[it][r1][3], Wb12);
                    bfly4(x[it][r1][0], x[it][r1][1], x[it][r1][2], x[it][r1][3], true);
                }
#pragma unroll
                for (int r2 = 0; r2 < 4; ++r2) {
                    x[it][1][r2] = cmulcf(x[it][1][r2], cmulf(Wb, mk2(CR[r2], CI[r2])));
                    x[it][2][r2] = cmulcf(x[it][2][r2], cmulf(Wb2, mk2(CR[2 * r2], CI[2 * r2])));
                    x[it][3][r2] = cmulcf(x[it][3][r2], cmulf(Wb3, mk2(CR[3 * r2], CI[3 * r2])));
                    bfly4(x[it][0][r2], x[it][1][r2], x[it][2][r2], x[it][3][r2], true);
                }
            }
        }
#pragma unroll
        for (int it = 0; it < 2; ++it)
#pragma unroll
            for (int r1 = 0; r1 < 4; ++r1)
#pragma unroll
                for (int r2 = 0; r2 < 4; ++r2) buf[base[it] + r1 * os + r2 * o1] = x[it][r1][r2];
    }
}
HD void ks_store(f32x4* p, f32x4 v) { *p = v; }
HD f32x4 ks_load(const f32x4* p) { return *p; }
HD unsigned ks_pk(float lo, float hi) {
#if defined(__HIP_DEVICE_COMPILE__)
    return cvt_pk_bf16(lo, hi);
#else
    unsigned a, b; __builtin_memcpy(&a, &lo, 4); __builtin_memcpy(&b, &hi, 4); a += 0x7fffu + ((a >> 16) & 1u); b += 0x7fffu + ((b >> 16) & 1u); return (a >> 16) | (b & 0xffff0000u);
#endif
}
HD float ks_up(unsigned h) { const unsigned u = h << 16; float f; __builtin_memcpy(&f, &u, 4); return f; }
HD void ks_store(u32x2* p, f32x4 v) { u32x2 w; w.x = ks_pk(v[0], v[1]); w.y = ks_pk(v[2], v[3]); *p = w; }
HD f32x4 ks_load(const u32x2* p) { const u32x2 w = *p; f32x4 r; r[0] = ks_up(w.x & 0xffffu); r[1] = ks_up(w.x >> 16); r[2] = ks_up(w.y & 0xffffu); r[3] = ks_up(w.y >> 16); return r; }
template <class P2, class K4>
HD void fft_make_ks(P2 buf, K4 ks, float scale, int tid, int nthr) {
    for (int f = tid; f <= FN / 2; f += nthr) {
        const int p = drev4(f), pp = drev4((FN - f) & (FN - 1));
        const f32x2 Ak = buf[fpad(p)], Bk = buf[fpad(pp)];
        const float h = 0.5f * scale;
        f32x4 o; o[0] = h * (Ak.x + Bk.x); o[1] = h * (Ak.y - Bk.y); o[2] = h * (Ak.y + Bk.y); o[3] = -h * (Ak.x - Bk.x);
        ks_store(ks + f, o);
    }
}
template <class P2, class TT, class K4>
HD void fft_pointwise(P2 buf, K4 ks, int tid, int nthr, TT T1, TT T2) {
#if defined(__HIP_DEVICE_COMPILE__)
#pragma unroll 4
#endif
    for (int f = tid; f <= FN / 2; f += nthr) {
        const int p = drev4(f), pp = drev4((FN - f) & (FN - 1));
        const f32x4 kv = ks_load(ks + f);
        const f32x2 A = buf[fpad(p)], Bq = buf[fpad(pp)];
        const f32x2 Ve = mk2(0.5f * (A.x + Bq.x), 0.5f * (A.y - Bq.y)), Vo = mk2(0.5f * (A.y + Bq.y), -0.5f * (A.x - Bq.x));
        const f32x2 Ke = mk2(kv[0], kv[1]), Ko = mk2(kv[2], kv[3]);
        const f32x2 oo = cmulf(twid(T1, T2, f), cmulf(Vo, Ko)), ee = cmulf(Ve, Ke);
        const f32x2 Ye = mk2(ee.x + oo.x, ee.y + oo.y);
        const f32x2 eo = cmulf(Ve, Ko), oe = cmulf(Vo, Ke);
        const f32x2 Yo = mk2(eo.x + oe.x, eo.y + oe.y);
        buf[fpad(p)] = mk2(Ye.x - Yo.y, Ye.y + Yo.x);
        if (pp != p) buf[fpad(pp)] = mk2(Ye.x + Yo.y, -Ye.y + Yo.x);
    }
}
#define FFT_FWD(buf, tid, nthr, T1, T2, SYNC) do { fft_pass4<false>(buf, tid, nthr, T1, T2); SYNC; fft_pass16<false>(buf, 1, tid, nthr, T1, T2); SYNC; fft_pass16<false>(buf, 3, tid, nthr, T1, T2); SYNC; fft_pass16<false>(buf, 5, tid, nthr, T1, T2); SYNC; } while (0)
#define FFT_FWD_H(buf, tid, nthr, T1, T2, SYNC) do { fft_pass4<false, true>(buf, tid, nthr, T1, T2); SYNC; fft_pass16<false>(buf, 1, tid, nthr, T1, T2); SYNC; fft_pass16<false>(buf, 3, tid, nthr, T1, T2); SYNC; fft_pass16<false>(buf, 5, tid, nthr, T1, T2); SYNC; } while (0)
#define FFT_INV_H(buf, tid, nthr, T1, T2, SYNC) do { fft_pass16<true>(buf, 5, tid, nthr, T1, T2); SYNC; fft_pass16<true>(buf, 3, tid, nthr, T1, T2); SYNC; fft_pass16<true>(buf, 1, tid, nthr, T1, T2); SYNC; fft_pass4<true, true>(buf, tid, nthr, T1, T2); SYNC; } while (0)
#define FFT_INV(buf, tid, nthr, T1, T2, SYNC) do { fft_pass16<true>(buf, 5, tid, nthr, T1, T2); SYNC; fft_pass16<true>(buf, 3, tid, nthr, T1, T2); SYNC; fft_pass16<true>(buf, 1, tid, nthr, T1, T2); SYNC; fft_pass4<true>(buf, tid, nthr, T1, T2); SYNC; } while (0)

#if !defined(HOST_TEST)
struct CvtJob { const float* src; bf16* dst; const float* shift; float* sw; const float* fg; const float* fs; bf16* dst2; int K, N, kind, tile0; };
constexpr int NJOBS = 16;
struct Args {
    const float* in[29]; float* out; unsigned char* ws; CvtJob jobs[NJOBS]; int ph_lo, ph_hi, ncvt, ncvt_early, ncvt_p1, pad1;
};
enum { I_X = 0, I_C, I_CTX, I_CCTX, I_ADAW, I_ADAB, I_NORMG, I_WG, I_WU, I_WD, I_EVWIN, I_CONVW, I_CONVB, I_HW1, I_HB1, I_HF1, I_HW2, I_HB2, I_HF2, I_HW3, I_SKIP, I_SINK, I_EVWOUT,
       I_ODWIN, I_SGG, I_SGWS, I_SGBS, I_ODWOUT, I_FING };

constexpr int N_ADA = 288, N_TAB = 1, N_FILT = 128;
DEV int cvt_map(int kind, int n) {
    if (kind == 1) return (n >> 7) * 256 + (n & 127);
    if (kind == 2) return (n >> 7) * 256 + 128 + (n & 127);
    if (kind == 3) {
        if (n < HYIN) return n;
        if (n >= HYIN + 1280) return HYIN + (n - (HYIN + 1280));
        const int d = n & 127; return 256 + (n & ~127) + (d < 64 ? 2 * d : 2 * (d - 64) + 1);
    }
    return n;
}
DEV void cvt_issue(const CvtJob& J, int tile, int tid, f32x4 (&v)[8]) {
    const int ntn = J.N >> 7, kt = tile / ntn, nt = tile - kt * ntn;
    const int wv_ = tid >> 6, ln_ = tid & 63, ko = 8 * (wv_ & 1) + (ln_ >> 3), nq = 8 * (wv_ >> 1) + (ln_ & 7);
    const float* src = J.src + (size_t)(kt * 128 + ko * 8) * J.N + nt * 128 + nq * 4;
#pragma unroll
    for (int i = 0; i < 8; ++i) v[i] = __builtin_nontemporal_load((const f32x4*)(src + (size_t)i * J.N));
}
DEV void cvt_finish(const CvtJob& J, int tile, int tid, const f32x4 (&v)[8]) {
    const int ntn = J.N >> 7, kt = tile / ntn, nt = tile - kt * ntn;
    const int wv_ = tid >> 6, ln_ = tid & 63, ko = 8 * (wv_ & 1) + (ln_ >> 3), nq = 8 * (wv_ >> 1) + (ln_ & 7);
    float f[8];
    if (J.shift) {
        const f32x4 g0 = *(const f32x4*)(J.fg + kt * 128 + ko * 8), g1 = *(const f32x4*)(J.fg + kt * 128 + ko * 8 + 4), c0 = *(const f32x4*)(J.fs + kt * 128 + ko * 8), c1 = *(const f32x4*)(J.fs + kt * 128 + ko * 8 + 4);
#pragma unroll
        for (int i = 0; i < 4; ++i) { f[i] = g0[i] * (1.0f + c0[i]); f[4 + i] = g1[i] * (1.0f + c1[i]); }
    } else {
#pragma unroll
        for (int i = 0; i < 8; ++i) f[i] = 1.0f;
    }
#pragma unroll
    for (int j = 0; j < 4; ++j) {
        u32x4 w; w.x = cvt_pk_bf16(v[0][j] * f[0], v[1][j] * f[1]); w.y = cvt_pk_bf16(v[2][j] * f[2], v[3][j] * f[3]); w.z = cvt_pk_bf16(v[4][j] * f[4], v[5][j] * f[5]); w.w = cvt_pk_bf16(v[6][j] * f[6], v[7][j] * f[7]);
        const int n = nt * 128 + nq * 4 + j, drow = cvt_map(J.kind, n);
        *(u32x4*)(J.dst + (size_t)drow * J.K + kt * 128 + ko * 8) = w;
        if (J.dst2 && n >= HYIN + 1024) {
            u32x4 wu; wu.x = cvt_pk_bf16(v[0][j], v[1][j]); wu.y = cvt_pk_bf16(v[2][j], v[3][j]); wu.z = cvt_pk_bf16(v[4][j], v[5][j]); wu.w = cvt_pk_bf16(v[6][j], v[7][j]);
            const int r2 = (n >= HYIN + 1280) ? (n - (HYIN + 1280)) : 256 + (drow - (NZT + 1024));
            *(u32x4*)(J.dst2 + (size_t)r2 * J.K + kt * 128 + ko * 8) = wu;
        }
    }
    if (J.shift) {
        const f32x4 s0 = *(const f32x4*)(J.shift + kt * 128 + ko * 8), s1 = *(const f32x4*)(J.shift + kt * 128 + ko * 8 + 4);
        f32x4 p = v[0] * s0[0] + v[1] * s0[1] + v[2] * s0[2] + v[3] * s0[3] + v[4] * s1[0] + v[5] * s1[1] + v[6] * s1[2] + v[7] * s1[3];
#pragma unroll
        for (int j = 0; j < 4; ++j) { float t = p[j]; t += __shfl_xor(t, 8); t += __shfl_xor(t, 16); t += __shfl_xor(t, 32); p[j] = t; }
        if (ln_ < 8) {
#pragma unroll
            for (int j = 0; j < 4; ++j) atomicAdd(J.sw + cvt_map(J.kind, nt * 128 + nq * 4 + j), p[j]);
        }
    }
}
DEV int cvt_job_of(const Args& a, int t) {
    int j = 0;
#pragma unroll 1
    for (int q = 1; q < NJOBS; ++q) if (t >= a.jobs[q].tile0) j = q;
    return j;
}
DEV void cvt_tile(const Args& a, int t, int tid) { const int j = cvt_job_of(a, t); f32x4 v[8]; cvt_issue(a.jobs[j], t - a.jobs[j].tile0, tid, v); cvt_finish(a.jobs[j], t - a.jobs[j].tile0, tid, v); }
DEV void ada_unit(const Args& a, unsigned char* ws, int u, LAS unsigned char* lds, int tid) {
    LAS float* sv = (LAS float*)lds;
    LAS float* red = (LAS float*)(lds + 16384);
    const int l = u / 144, cg = u - l * 144, n0 = cg * 128, w = tid >> 6, lane = tid & 63, rsub = lane >> 5, c4 = lane & 31;
    for (int k = tid; k < D; k += NTHR) { const float c = a.in[I_C][k], cc = a.in[I_CCTX][k]; sv[k] = c / (1.0f + expf(-c)); sv[D + k] = cc / (1.0f + expf(-cc)); }
    __syncthreads();
    const float* W = a.in[I_ADAW] + (size_t)l * D * (NMOD * D) + n0 + 4 * c4;
    f32x4 al = (f32x4){0.f, 0.f, 0.f, 0.f}, ac = al;
    const int k0 = w * 256 + rsub;
#pragma unroll 1
    for (int kk = 0; kk < 256; kk += 32) {
        f32x4 wv[16];
#pragma unroll
        for (int i = 0; i < 16; ++i) wv[i] = __builtin_nontemporal_load((const f32x4*)(W + (size_t)(k0 + kk + 2 * i) * (NMOD * D)));
#pragma unroll
        for (int i = 0; i < 16; ++i) { const float sl = sv[k0 + kk + 2 * i], sc = sv[D + k0 + kk + 2 * i]; al += wv[i] * sl; ac += wv[i] * sc; }
    }
#pragma unroll
    for (int j = 0; j < 4; ++j) { al[j] += __shfl_xor(al[j], 32); ac[j] += __shfl_xor(ac[j], 32); }
    if (rsub == 0) { *(LAS f32x4*)(red + (w * 2 + 0) * 128 + 4 * c4) = al; *(LAS f32x4*)(red + (w * 2 + 1) * 128 + 4 * c4) = ac; }
    __syncthreads();
    if (tid < 256) {
        const int sI = tid >> 7, col = tid & 127;
        float t = 0.f;
#pragma unroll
        for (int ww = 0; ww < 8; ++ww) t += red[(ww * 2 + sI) * 128 + col];
        float* mod = (float*)(ws + WS_MOD);
        mod[(size_t)(l * 2 + sI) * (NMOD * D) + n0 + col] = t + a.in[I_ADAB][(size_t)l * (NMOD * D) + n0 + col];
    }
    __syncthreads();
}
DEV void table_unit(const Args& a, unsigned char* ws, int which, int tid) {
    f32x2* tab = (f32x2*)(ws + WS_ROPE);
    for (int i = tid; i < 256 * 32; i += NTHR) { const int pos = i >> 5, f = i & 31; const float inv = powf(10000.0f, -(float)f / 32.0f); const float ang = (float)pos * inv; tab[i] = (f32x2){cosf(ang), sinf(ang)}; }
}
typedef float f32x16 __attribute__((ext_vector_type(16)));
DEV void split_bf16x8(const float (&x)[8], bf16x8& hi, bf16x8& lo) {
    u32x4 h, l;
#pragma unroll
    for (int i = 0; i < 4; ++i) { const unsigned hw = cvt_pk_bf16(x[2 * i], x[2 * i + 1]); h[i] = hw; l[i] = cvt_pk_bf16(x[2 * i] - bflo(hw), x[2 * i + 1] - bfhi(hw)); }
    __builtin_memcpy(&hi, &h, 16); __builtin_memcpy(&lo, &l, 16);
}
DEV void filter_unit(const Args& a, unsigned char* ws, int fu, LAS unsigned char* lds, int tid) {
    constexpr int HP = 72;
    const int n0 = fu * 128, w = __builtin_amdgcn_readfirstlane(tid >> 6), lane = tid & 63, c = lane & 31, hi = lane >> 5;
    LAS unsigned short* H2hi = (LAS unsigned short*)lds; LAS unsigned short* H2lo = H2hi + 128 * HP;
    LAS float* zrow = (LAS float*)(lds + 2 * 128 * HP * 2) + w * 40; LAS float* h1row = (LAS float*)(lds + 2 * 128 * HP * 2 + 8 * 160) + w * 64;
    {
        LAS float* wst = (LAS float*)(lds + 2 * 128 * HP * 2 + 8 * 160 + 8 * 256);
        for (int i = tid; i < 33 * 64; i += NTHR) wst[i] = a.in[I_HW1][i];
        for (int i = tid; i < 64 * 64; i += NTHR) wst[33 * 64 + i] = a.in[I_HW2][i];
        __syncthreads();
        float w1c[33], w2c[64];
#pragma unroll
        for (int i = 0; i < 33; ++i) w1c[i] = wst[i * 64 + lane];
#pragma unroll
        for (int i = 0; i < 64; ++i) w2c[i] = wst[33 * 64 + i * 64 + lane];
        const float b1 = a.in[I_HB1][lane], f1 = a.in[I_HF1][lane], b2 = a.in[I_HB2][lane], f2 = a.in[I_HF2][lane];
#pragma unroll 1
        for (int i = 0; i < 16; ++i) {
            const int nl = w * 16 + i, n = n0 + nl;
            if (lane < 33) {
                float z;
                if (lane == 0) z = (float)n / (float)(SEQ - 1);
                else { const int b = (lane - 1) & 15; const float band = 1e-4f + (float)b * ((15.0f - 1e-4f) / 15.0f); const float wv = (6.283185307179586f / (float)SEQ) * (float)n; const float ang = band * wv; z = (lane <= 16) ? cosf(ang) : -sinf(ang); }
                zrow[lane] = z;
            }
            __builtin_amdgcn_wave_barrier();
            float s1 = b1;
#pragma unroll
            for (int k = 0; k < 33; ++k) s1 += zrow[k] * w1c[k];
            h1row[lane] = sinf(f1 * s1);
            __builtin_amdgcn_wave_barrier();
            float s2 = b2;
#pragma unroll
            for (int k = 0; k < 64; k += 4) { const f32x4 hv = *(const LAS f32x4*)(h1row + k); s2 += hv[0] * w2c[k] + hv[1] * w2c[k + 1] + hv[2] * w2c[k + 2] + hv[3] * w2c[k + 3]; }
            const float h2 = sinf(f2 * s2);
            const unsigned hw = cvt_pk_bf16(h2, 0.f); const unsigned lw = cvt_pk_bf16(h2 - bflo(hw), 0.f);
            H2hi[nl * HP + lane] = (unsigned short)(hw & 0xffffu); H2lo[nl * HP + lane] = (unsigned short)(lw & 0xffffu);
            __builtin_amdgcn_wave_barrier();
        }
    }
    __syncthreads();
    const float lt = -4.605170185988091f, d0 = lt / 1.5f, d1 = lt / 0.3f;
    bf16* kt = (bf16*)(ws + WS_KT);
    const float* w3 = a.in[I_HW3];
#pragma unroll 1
    for (int rb = 0; rb < 8; ++rb) {
        const int cp0 = w * 256 + rb * 32;
        bf16x8 Ah[4], Al[4];
#pragma unroll
        for (int ks = 0; ks < 4; ++ks) {
            float x[8];
#pragma unroll
            for (int i = 0; i < 8; ++i) x[i] = w3[(size_t)(ks * 16 + 8 * hi + i) * (2 * HYW) + cp0 + c];
            split_bf16x8(x, Ah[ks], Al[ks]);
        }
#pragma unroll 1
        for (int nb = 0; nb < 4; ++nb) {
            f32x16 acc;
#pragma unroll
            for (int r = 0; r < 16; ++r) acc[r] = 0.f;
#pragma unroll
            for (int ks = 0; ks < 4; ++ks) {
                const bf16x8 bh = *(const LAS bf16x8*)((const LAS unsigned char*)H2hi + ((nb * 32 + c) * HP + ks * 16 + 8 * hi) * 2);
                const bf16x8 bl = *(const LAS bf16x8*)((const LAS unsigned char*)H2lo + ((nb * 32 + c) * HP + ks * 16 + 8 * hi) * 2);
                acc = __builtin_amdgcn_mfma_f32_32x32x16_bf16(Ah[ks], bh, acc, 0, 0, 0);
                acc = __builtin_amdgcn_mfma_f32_32x32x16_bf16(Ah[ks], bl, acc, 0, 0, 0);
                acc = __builtin_amdgcn_mfma_f32_32x32x16_bf16(Al[ks], bh, acc, 0, 0, 0);
            }
            const int n = n0 + nb * 32 + c;
            const float tn = (float)n / (float)(SEQ - 1) * 1.4426950408889634f;
#pragma unroll
            for (int r = 0; r < 16; ++r) {
                const int cp = cp0 + (r & 3) + 8 * (r >> 2) + 4 * hi, dir = cp >> 10, ch = cp & 1023;
                const float delta = fabsf(d0 + (d1 - d0) * ((float)ch / (float)(HYW - 1)));
                kt[((size_t)ch * 2 + dir) * SEQ + n] = (bf16)(cvt_pk_bf16(acc[r] * __builtin_amdgcn_exp2f(-tn * delta), 0.f) & 0xffffu);
            }
        }
    }
    __syncthreads();
}
DEV int cvt_start(int b) { const int f = b - 33; return 24 * b - 5 * (b < 32 ? b : 32) - 8 * (f < 0 ? 0 : (f > 128 ? 128 : f)); }
DEV void phase_prologue(const Args& a, unsigned char* ws, LAS unsigned char* lds, int bid, int nb, int tid) {
    const int total = N_ADA + N_TAB + N_FILT;
    for (int it = bid; it < total; it += nb) {
        if (it < N_ADA) ada_unit(a, ws, it, lds, tid);
        else if (it < N_ADA + N_TAB) table_unit(a, ws, it - N_ADA, tid);
        else filter_unit(a, ws, it - N_ADA - N_TAB, lds, tid);
    }
    if (nb == 256) { int t0 = cvt_start(bid), t1 = cvt_start(bid + 1); if (t1 > a.ncvt_early || bid == 255) t1 = a.ncvt_early; for (int t = t0; t < t1; ++t) cvt_tile(a, t, tid); }
    else for (int t = bid; t < a.ncvt_early; t += nb) cvt_tile(a, t, tid);
}
DEV void phase_norm(const float* xlat, const float* xc, int nrows, const float* g, const float* mod_lat, const float* mod_ctx, int kshift, bf16* XN, float* xc_copy, LAS unsigned char* lds, int bid, int nb, int tid) {
    LAS float* gs = (LAS float*)lds;
    LAS float* sh = gs + 2 * D;
    for (int k = tid; k < D; k += NTHR) {
        const float gg = g[k];
        gs[k] = gg * (1.0f + mod_lat[(kshift + 1) * D + k]); sh[k] = mod_lat[kshift * D + k];
        gs[D + k] = gg * (1.0f + mod_ctx[(kshift + 1) * D + k]); sh[D + k] = mod_ctx[kshift * D + k];
    }
    __syncthreads();
    const int w = tid >> 6, lane = tid & 63;
    for (int r0 = (bid * 8 + w) * 2; r0 < nrows; r0 += nb * 16) {
        f32x4 v[2][8]; float ss[2];
#pragma unroll
        for (int h = 0; h < 2; ++h) {
            const int r = r0 + h; const bool cx = r >= SEQ;
            const float* src = cx ? xc + (size_t)(r - SEQ) * D : xlat + (size_t)r * D;
#pragma unroll
            for (int i = 0; i < 8; ++i) v[h][i] = (r < nrows) ? *(const f32x4*)(src + (i * 64 + lane) * 4) : (f32x4){0.f, 0.f, 0.f, 0.f};
        }
#pragma unroll
        for (int h = 0; h < 2; ++h) {
            const int r = r0 + h; const bool cx = r >= SEQ;
            if (r >= nrows) break;
            float s2 = 0.f;
#pragma unroll
            for (int i = 0; i < 8; ++i) s2 += v[h][i][0] * v[h][i][0] + v[h][i][1] * v[h][i][1] + v[h][i][2] * v[h][i][2] + v[h][i][3] * v[h][i][3];
            if (cx && xc_copy) {
#pragma unroll
                for (int i = 0; i < 8; ++i) *(f32x4*)(xc_copy + (size_t)(r - SEQ) * D + (i * 64 + lane) * 4) = v[h][i]; }
            ss[h] = wave_sum(s2);
            const float rstd = 1.0f / sqrtf(ss[h] * (1.0f / D) + EPS);
            const LAS float* gp = gs + (cx ? D : 0); const LAS float* sp = sh + (cx ? D : 0);
#pragma unroll
            for (int i = 0; i < 8; ++i) {
                const int col = (i * 64 + lane) * 4;
                const f32x4 gv = *(const LAS f32x4*)(gp + col), sv = *(const LAS f32x4*)(sp + col);
                const f32x4 y = v[h][i] * rstd * gv + sv;
                u32x2 o; o.x = cvt_pk_bf16(y[0], y[1]); o.y = cvt_pk_bf16(y[2], y[3]);
                *(u32x2*)(XN + (size_t)r * D + col) = o;
            }
        }
    }
}
DEV void ctx_norm_block(const float* XC, const float* g, const float* mod_ctx, int kshift, bf16* XNctx, int tid, LAS unsigned char* lds) {
    LAS float* gsv = (LAS float*)lds; LAS float* shv = gsv + D;
    for (int k = tid; k < D; k += NTHR) { gsv[k] = g[k] * (1.0f + mod_ctx[(kshift + 1) * D + k]); shv[k] = mod_ctx[kshift * D + k]; }
    __syncthreads();
    const int w = tid >> 6, lane = tid & 63;
    for (int r0 = w * 4; r0 < NCTX; r0 += 32) {
        f32x4 v[4][8];
#pragma unroll
        for (int h = 0; h < 4; ++h)
#pragma unroll
            for (int i = 0; i < 8; ++i) v[h][i] = *(const f32x4*)(XC + (size_t)(r0 + h) * D + (i * 64 + lane) * 4);
#pragma unroll
        for (int h = 0; h < 4; ++h) {
            const int r = r0 + h; float ss = 0.f;
#pragma unroll
            for (int i = 0; i < 8; ++i) ss += v[h][i][0] * v[h][i][0] + v[h][i][1] * v[h][i][1] + v[h][i][2] * v[h][i][2] + v[h][i][3] * v[h][i][3];
            ss = wave_sum(ss);
            const float rstd = 1.0f / sqrtf(ss * (1.0f / D) + EPS);
#pragma unroll
            for (int i = 0; i < 8; ++i) {
                const int col = (i * 64 + lane) * 4;
                const f32x4 gv = *(const LAS f32x4*)(gsv + col), sh = *(const LAS f32x4*)(shv + col);
                const f32x4 y = v[h][i] * rstd * gv + sh;
                u32x2 o; o.x = cvt_pk_bf16(y[0], y[1]); o.y = cvt_pk_bf16(y[2], y[3]);
                *(u32x2*)(XNctx + (size_t)r * D + col) = o;
            }
        }
    }
    asm volatile("s_waitcnt vmcnt(0)" ::: "memory");
    __syncthreads();
}
DEV void phase_final_norm(const bf16* xb, float* out, const float* g, int bid, int nb, int tid) {
    const int w = tid >> 6, lane = tid & 63;
    for (int r0 = (bid * 8 + w) * 2; r0 < SEQ; r0 += nb * 16) {
        u32x4 q[2][4];
#pragma unroll
        for (int h = 0; h < 2; ++h)
#pragma unroll
            for (int i = 0; i < 4; ++i) q[h][i] = *(const u32x4*)(xb + (size_t)(r0 + h) * D + (i * 64 + lane) * 8);
#pragma unroll
        for (int h = 0; h < 2; ++h) {
            float v[4][8]; float ss = 0.f;
#pragma unroll
            for (int i = 0; i < 4; ++i) { v[i][0] = bflo(q[h][i].x); v[i][1] = bfhi(q[h][i].x); v[i][2] = bflo(q[h][i].y); v[i][3] = bfhi(q[h][i].y); v[i][4] = bflo(q[h][i].z); v[i][5] = bfhi(q[h][i].z); v[i][6] = bflo(q[h][i].w); v[i][7] = bfhi(q[h][i].w);
#pragma unroll
                for (int j = 0; j < 8; ++j) ss += v[i][j] * v[i][j]; }
            ss = wave_sum(ss);
            const float rstd = 1.0f / sqrtf(ss * (1.0f / D) + EPS);
#pragma unroll
            for (int i = 0; i < 4; ++i) {
                const int col = (i * 64 + lane) * 8; const f32x4 g0 = *(const f32x4*)(g + col), g1 = *(const f32x4*)(g + col + 4);
                *(f32x4*)(out + (size_t)(r0 + h) * D + col) = (f32x4){v[i][0] * rstd * g0[0], v[i][1] * rstd * g0[1], v[i][2] * rstd * g0[2], v[i][3] * rstd * g0[3]};
                *(f32x4*)(out + (size_t)(r0 + h) * D + col + 4) = (f32x4){v[i][4] * rstd * g1[0], v[i][5] * rstd * g1[1], v[i][6] * rstd * g1[2], v[i][7] * rstd * g1[3]};
            }
        }
    }
}

typedef __attribute__((address_space(1))) unsigned char* gptr_t;
DEV unsigned char* fresh_ptr(unsigned char* p) { gptr_t g = (gptr_t)p; asm volatile("" : "+s"(g)); return (unsigned char*)g; }
constexpr int HY_RED = FBUF * 8, HY_T1 = HY_RED + 64, HY_T2 = HY_T1 + 1040;
DEV void hyena_tables(LAS unsigned char* lds, int tid) {
    LAS f32x2* T1 = (LAS f32x2*)(lds + HY_T1); LAS f32x2* T2 = (LAS f32x2*)(lds + HY_T2);
    if (tid < 129) { float sn, cs; sincospif(2.0f * (float)(64 * tid) / (float)FN, &sn, &cs); T1[tid] = mk2(cs, -sn); }
    else if (tid >= 192 && tid < 256) { const int k = tid - 192; float sn, cs; sincospif(2.0f * (float)k / (float)FN, &sn, &cs); T2[k] = mk2(cs, -sn); }
    __syncthreads();
}
DEV f32x2 conv3_pair(unsigned wp, unsigned wc, unsigned wn, int t, float w0, float w1, float w2, float b) {
    const float zm = (t > 0) ? bfhi(wp) : 0.f, z0 = bflo(wc), z1 = bfhi(wc), z2 = (t + 2 < SEQ) ? bflo(wn) : 0.f;
    return mk2(w0 * zm + w1 * z0 + w2 * z1 + b, w0 * z0 + w1 * z1 + w2 * z2 + b);
}
DEV void phase_filter_fft(const Args& a, unsigned char* ws, LAS unsigned char* lds, int bid, int nb, int tid_in) {
    hyena_tables(lds, tid_in);
    LAS f32x2* buf = (LAS f32x2*)lds; LAS float* red = (LAS float*)(lds + HY_RED);
    const LAS f32x2* T1 = (const LAS f32x2*)(lds + HY_T1); const LAS f32x2* T2 = (const LAS f32x2*)(lds + HY_T2);
    f32x4 cv[8]; int ct = a.ncvt_early + bid, cj = 0, cpend = 0;
#define CVT_HOOK do { if (cpend) { cvt_finish(a.jobs[cj], ct - a.jobs[cj].tile0, tid_in, cv); ct += nb; cpend = 0; } \
        if (ct < a.ncvt_p1) { cj = cvt_job_of(a, ct); cvt_issue(a.jobs[cj], ct - a.jobs[cj].tile0, tid_in, cv); cpend = 1; } } while (0)
#define HY_SYNC_HOOK do { __syncthreads(); CVT_HOOK; } while (0)
    for (int c = bid; c < HYW; c += nb) {
        int tid = tid_in; asm volatile("" : "+v"(tid));
        const bf16* hf = (const bf16*)(ws + WS_KT) + (size_t)c * 2 * SEQ; const bf16* hb = hf + SEQ;
        float ssq = 0.f;
        {
            f32x2 v[16];
#pragma unroll
            for (int k = 0; k < 16; ++k) { const unsigned wq = *(const unsigned*)(hf + 2 * (tid + NTHR * k)); v[k] = mk2(bflo(wq), bfhi(wq)); }
#pragma unroll
            for (int k = 0; k < 16; ++k) { ssq += v[k].x * v[k].x + v[k].y * v[k].y; buf[fpad(tid + NTHR * k)] = v[k]; }
            asm volatile("" ::: "memory");
#pragma unroll
            for (int k = 0; k < 16; ++k) { const int n = FN / 2 + tid + NTHR * k; v[k].x = (2 * n == SEQ) ? 0.f : bf2f(hb[2 * SEQ - 2 * n]); v[k].y = bf2f(hb[2 * SEQ - 2 * n - 1]); }
#pragma unroll
            for (int k = 0; k < 16; ++k) { ssq += v[k].x * v[k].x + v[k].y * v[k].y; buf[fpad(FN / 2 + tid + NTHR * k)] = v[k]; }
        }
        ssq = wave_sum(ssq);
        if ((tid & 63) == 0) red[tid >> 6] = ssq;
        HY_SYNC_HOOK;
        float tot = 0.f;
#pragma unroll
        for (int i = 0; i < 8; ++i) tot += red[i];
        const float rho = 1.0f / sqrtf(tot + EPS);
        FFT_FWD(buf, tid, NTHR, T1, T2, HY_SYNC_HOOK);
        fft_make_ks(buf, (u32x2*)(ws + WS_KS) + (size_t)c * KSP, rho * (1.0f / (float)FN), tid, NTHR);
        HY_SYNC_HOOK;
    }
    if (cpend) { cvt_finish(a.jobs[cj], ct - a.jobs[cj].tile0, tid_in, cv); ct += nb; }
    for (; ct < a.ncvt_p1; ct += nb) cvt_tile(a, ct, tid_in);
#undef CVT_HOOK
#undef HY_SYNC_HOOK
}
DEV void hyena_channel(const Args& a, unsigned char* ws, int c, LAS unsigned char* lds, int bid, int tid_in) {
    int tid = tid_in; asm volatile("" : "+v"(tid));
    LAS f32x2* buf = (LAS f32x2*)lds;
    const LAS f32x2* T1 = (const LAS f32x2*)(lds + HY_T1); const LAS f32x2* T2 = (const LAS f32x2*)(lds + HY_T2);
    const bf16* ZT = (const bf16*)(ws + WS_ZT);
    const bf16* r0 = ZT + (size_t)c * ZTP; const bf16* r1 = ZT + (size_t)(HYW + c) * ZTP; const bf16* r2 = ZT + (size_t)(2 * HYW + c) * ZTP;
    const float* cw = a.in[I_CONVW]; const float* cb = a.in[I_CONVB];
    const float w00 = cw[c], w01 = cw[HYIN + c], w02 = cw[2 * HYIN + c], b0 = cb[c];
    const float w10 = cw[HYW + c], w11 = cw[HYIN + HYW + c], w12 = cw[2 * HYIN + HYW + c], b1 = cb[HYW + c];
    const float w20 = cw[2 * HYW + c], w21 = cw[HYIN + 2 * HYW + c], w22 = cw[2 * HYIN + 2 * HYW + c], b2 = cb[2 * HYW + c];
    unsigned uq[16], xq[16];
    const float skip = a.in[I_SKIP][c];
#pragma unroll
    for (int kb = 0; kb < 16; kb += 4) {
        unsigned wd[4][3][3];
#pragma unroll
        for (int k = 0; k < 4; ++k) {
            const int t = 2 * (tid + NTHR * (kb + k)); const int tp = t > 0 ? t - 2 : 0;
            wd[k][0][0] = *(const unsigned*)(r0 + tp); wd[k][0][1] = *(const unsigned*)(r0 + t); wd[k][0][2] = *(const unsigned*)(r0 + t + 2);
            wd[k][1][0] = *(const unsigned*)(r1 + tp); wd[k][1][1] = *(const unsigned*)(r1 + t); wd[k][1][2] = *(const unsigned*)(r1 + t + 2);
            wd[k][2][0] = *(const unsigned*)(r2 + tp); wd[k][2][1] = *(const unsigned*)(r2 + t); wd[k][2][2] = *(const unsigned*)(r2 + t + 2);
        }
#pragma unroll
        for (int k = 0; k < 4; ++k) {
            const int n = tid + NTHR * (kb + k), t = 2 * n;
            const f32x2 x0v = conv3_pair(wd[k][0][0], wd[k][0][1], wd[k][0][2], t, w00, w01, w02, b0);
            const f32x2 x1v = conv3_pair(wd[k][1][0], wd[k][1][1], wd[k][1][2], t, w10, w11, w12, b1), hvv = conv3_pair(wd[k][2][0], wd[k][2][1], wd[k][2][2], t, w20, w21, w22, b2);
            const f32x2 uv = hvv * x1v;
            xq[kb + k] = cvt_pk_bf16(x0v.x, x0v.y); uq[kb + k] = cvt_pk_bf16(uv.x * skip, uv.y * skip);
            buf[fpad(n)] = uv;
        }
        asm volatile("" ::: "memory");
    }
    __syncthreads();
    FFT_FWD_H(buf, tid, NTHR, T1, T2, __syncthreads());
    fft_pointwise(buf, (const u32x2*)(ws + WS_KS) + (size_t)c * KSP, tid, NTHR, T1, T2);
    __syncthreads();
    FFT_INV_H(buf, tid, NTHR, T1, T2, __syncthreads());
    bf16* YHT = (bf16*)(ws + WS_YHT) + (size_t)c * SEQ;
#pragma unroll
    for (int k = 0; k < 16; ++k) {
        const int n = tid + NTHR * k; const f32x2 y = buf[fpad(n)];
        *(unsigned*)(YHT + 2 * n) = cvt_pk_bf16(bflo(xq[k]) * (y.x + bflo(uq[k])), bfhi(xq[k]) * (y.y + bfhi(uq[k])));
    }
    __syncthreads();
}

constexpr int AT_KP = 136, AT_VP = 72;
constexpr int AT_KB = 64 * AT_KP * 2, AT_VB = 128 * AT_VP * 2;
DEV void phase_attn(unsigned char* ws, const float* sink, LAS unsigned char* lds, int bid, int nb, int tid) {
    const int w = __builtin_amdgcn_readfirstlane(tid >> 6), lane = tid & 63, c = lane & 31, hi = lane >> 5;
    const bf16* QK = (const bf16*)(ws + WS_QK); const bf16* ZT = (const bf16*)(ws + WS_ZT); bf16* Y = (bf16*)(ws + WS_YMIX);
    const float CS = 0.08838834764831845f * 1.4426950408889634f;
    for (int unit = bid; unit < 512; unit += nb) {
        const int qb = unit >> 1, kvh = unit & 1, q0 = qb * 64, h = kvh * 4 + (w >> 1), a0 = (w & 1) * 32, t = q0 + a0 + c;
        const int jlo = (2 - qb) > 0 ? (2 - qb) : 0, jhi = (257 - qb) < 4 ? (257 - qb) : 4, ntile = 4 + (jhi - jlo + 1);
        bf16x8 Qf[8];
#pragma unroll
        for (int ds = 0; ds < 8; ++ds) Qf[ds] = *(const bf16x8*)(QK + (size_t)t * NQK + h * 128 + ds * 16 + hi * 8);
        f32x16 O[4];
#pragma unroll
        for (int db = 0; db < 4; ++db)
#pragma unroll
            for (int r = 0; r < 16; ++r) O[db][r] = 0.f;
        float m = sink[h] * 1.4426950408889634f, l = (hi == 0) ? 1.0f : 0.0f;
        u32x4 stg[4];
        const int kr0 = (tid * 2) >> 4, kc0 = (tid * 2) & 15, vr0 = (tid * 2) >> 3, vc0 = (tid * 2) & 7;
#define AT_TOK(i) ((i) < 4 ? SEQ + 64 * (i) : q0 + (jlo + (i) - 4 - 2) * 64)
#define AT_LOAD(i) do { const int tok_ = AT_TOK(i); \
            stg[0] = *(const u32x4*)(QK + (size_t)(tok_ + kr0) * NQK + 1024 + kvh * 128 + kc0 * 8); stg[1] = *(const u32x4*)(QK + (size_t)(tok_ + kr0) * NQK + 1024 + kvh * 128 + kc0 * 8 + 8); \
            stg[2] = *(const u32x4*)(ZT + (size_t)(HYIN + kvh * 128 + vr0) * ZTP + tok_ + vc0 * 8); stg[3] = *(const u32x4*)(ZT + (size_t)(HYIN + kvh * 128 + vr0) * ZTP + tok_ + vc0 * 8 + 8); } while (0)
#define AT_STORE(b) do { *(LAS u32x4*)(lds + (b) * AT_KB + kr0 * (AT_KP * 2) + kc0 * 16) = stg[0]; *(LAS u32x4*)(lds + (b) * AT_KB + kr0 * (AT_KP * 2) + kc0 * 16 + 16) = stg[1]; \
            *(LAS u32x4*)(lds + 2 * AT_KB + (b) * AT_VB + vr0 * (AT_VP * 2) + vc0 * 16) = stg[2]; *(LAS u32x4*)(lds + 2 * AT_KB + (b) * AT_VB + vr0 * (AT_VP * 2) + vc0 * 16 + 16) = stg[3]; } while (0)
        AT_LOAD(0); AT_STORE(0);
        __syncthreads();
        for (int i = 0; i < ntile; ++i) {
            const int b = i & 1;
            if (i + 1 < ntile) AT_LOAD(i + 1);
            const int jj = (i < 4) ? 2 : (jlo + i - 4);
            const LAS unsigned char* Kb = lds + b * AT_KB; const LAS unsigned char* Vb = lds + 2 * AT_KB + b * AT_VB;
            f32x16 S[2];
#pragma unroll
            for (int kb2 = 0; kb2 < 2; ++kb2) {
#pragma unroll
                for (int r = 0; r < 16; ++r) S[kb2][r] = 0.f;
#pragma unroll
                for (int ds = 0; ds < 8; ++ds) { const bf16x8 kf = *(const LAS bf16x8*)(Kb + (kb2 * 32 + c) * (AT_KP * 2) + ds * 32 + hi * 16); S[kb2] = __builtin_amdgcn_mfma_f32_32x32x16_bf16(kf, Qf[ds], S[kb2], 0, 0, 0); }
            }
            if (jj == 0 || jj == 4) {
                const int a = a0 + c;
#pragma unroll
                for (int kb2 = 0; kb2 < 2; ++kb2)
#pragma unroll
                    for (int r = 0; r < 16; ++r) { const int kk = kb2 * 32 + (r & 3) + 8 * (r >> 2) + 4 * hi; const bool ok = (jj == 0) ? (kk >= a) : (kk <= a); S[kb2][r] = ok ? S[kb2][r] : -INFINITY; }
            }
            float mx = -INFINITY;
#pragma unroll
            for (int kb2 = 0; kb2 < 2; ++kb2)
#pragma unroll
                for (int r = 0; r < 16; r += 2) mx = fmaxf(fmaxf(mx, S[kb2][r]), S[kb2][r + 1]);
            mx = fmaxf(mx, __shfl_xor(mx, 32)) * CS;
            const float mn = fmaxf(m, mx), alpha = __builtin_amdgcn_exp2f(m - mn);
            m = mn;
            f32x2 ps2 = {0.f, 0.f};
#pragma unroll
            for (int kb2 = 0; kb2 < 2; ++kb2)
#pragma unroll
                for (int r = 0; r < 16; r += 2) {
                    const f32x2 tt = (f32x2){S[kb2][r], S[kb2][r + 1]} * CS - mn;
                    f32x2 p; p.x = __builtin_amdgcn_exp2f(tt.x); p.y = __builtin_amdgcn_exp2f(tt.y);
                    S[kb2][r] = p.x; S[kb2][r + 1] = p.y; ps2 += p;
                }
            l = l * alpha + (ps2.x + ps2.y);
#pragma unroll
            for (int db = 0; db < 4; ++db) O[db] *= alpha;
#pragma unroll
            for (int kk = 0; kk < 4; ++kk) {
                const int kb2 = kk >> 1, r0 = (kk & 1) * 8;
                u32x4 pw; pw.x = cvt_pk_bf16(S[kb2][r0], S[kb2][r0 + 1]); pw.y = cvt_pk_bf16(S[kb2][r0 + 2], S[kb2][r0 + 3]); pw.z = cvt_pk_bf16(S[kb2][r0 + 4], S[kb2][r0 + 5]); pw.w = cvt_pk_bf16(S[kb2][r0 + 6], S[kb2][r0 + 7]);
                bf16x8 pf; __builtin_memcpy(&pf, &pw, 16);
#pragma unroll
                for (int db = 0; db < 4; ++db) {
                    const LAS unsigned char* vp = Vb + (db * 32 + c) * (AT_VP * 2) + kk * 32 + hi * 8;
                    const u32x2 v0 = *(const LAS u32x2*)vp, v1 = *(const LAS u32x2*)(vp + 16);
                    u32x4 vw; vw.x = v0.x; vw.y = v0.y; vw.z = v1.x; vw.w = v1.y;
                    bf16x8 vf; __builtin_memcpy(&vf, &vw, 16);
                    O[db] = __builtin_amdgcn_mfma_f32_32x32x16_bf16(vf, pf, O[db], 0, 0, 0);
                }
            }
            if (i + 1 < ntile) AT_STORE(b ^ 1);
            __syncthreads();
        }
        const float lt = l + __shfl_xor(l, 32), inv = 1.0f / lt;
        bf16* yrow = Y + (size_t)t * D + HYW + h * 128;
#pragma unroll
        for (int db = 0; db < 4; ++db)
#pragma unroll
            for (int rq = 0; rq < 4; ++rq) {
                u32x2 o; o.x = cvt_pk_bf16(O[db][rq * 4] * inv, O[db][rq * 4 + 1] * inv); o.y = cvt_pk_bf16(O[db][rq * 4 + 2] * inv, O[db][rq * 4 + 3] * inv);
                *(u32x2*)(yrow + db * 32 + 8 * rq + 4 * hi) = o;
            }
#undef AT_TOK
#undef AT_LOAD
#undef AT_STORE
    }
}
DEV void phase_mixer(const Args& a, unsigned char* ws, LAS unsigned char* lds, int bid, int nb, int tid) {
    hyena_tables(lds, tid);
    const bool attn_first = ((bid >> 3) & 1) != 0;
    if (attn_first) phase_attn(ws, a.in[I_SINK], lds, bid, nb, tid);
    for (int c = bid; c < HYW; c += nb) hyena_channel(a, ws, c, lds, bid, tid);
    if (!attn_first) phase_attn(ws, a.in[I_SINK], lds, bid, nb, tid);
}
DEV void phase_transpose(const Args& a, unsigned char* ws, LAS unsigned char* lds, int bid, int nb, int tid) {
    LAS unsigned* T = (LAS unsigned*)lds;
    const LAS unsigned short* Th = (const LAS unsigned short*)lds;
    const bf16* YHT = (const bf16*)(ws + WS_YHT); bf16* Y = (bf16*)(ws + WS_YMIX);
    constexpr int NT = (HYW / 128) * (SEQ / 128);
    u32x4 v[4];
#define TR_LOAD(tile_) do { const int ct_ = (tile_) & 7, tt_ = (tile_) >> 3; _Pragma("unroll") for (int it = 0; it < 4; ++it) { const int item = it * NTHR + tid, cr = item >> 4, oc = item & 15; \
        v[it] = *(const u32x4*)(YHT + (size_t)(ct_ * 128 + cr) * SEQ + tt_ * 128 + oc * 8); } } while (0)
    if (bid < NT) TR_LOAD(bid);
    for (int tile = bid; tile < NT; tile += nb) {
        const int ct = tile & 7, tt = tile >> 3;
#pragma unroll
        for (int it = 0; it < 4; ++it) { const int item = it * NTHR + tid, cr = item >> 4, oc = item & 15; LAS unsigned* p = T + cr * 65 + oc * 4; p[0] = v[it].x; p[1] = v[it].y; p[2] = v[it].z; p[3] = v[it].w; }
        __syncthreads();
        if (tile + nb < NT) TR_LOAD(tile + nb);
#pragma unroll
        for (int it = 0; it < 4; ++it) {
            const int item = it * NTHR + tid, oct = item & 15, tl = item >> 4;
            unsigned short e[8];
#pragma unroll
            for (int i = 0; i < 8; ++i) e[i] = Th[(oct * 8 + i) * 130 + tl];
            u32x4 w; w.x = e[0] | ((unsigned)e[1] << 16); w.y = e[2] | ((unsigned)e[3] << 16); w.z = e[4] | ((unsigned)e[5] << 16); w.w = e[6] | ((unsigned)e[7] << 16);
            *(u32x4*)(Y + (size_t)(tt * 128 + tl) * D + ct * 128 + oct * 8) = w;
        }
        __syncthreads();
    }
#undef TR_LOAD
}
DEV void phase_spatial(const Args& a, unsigned char* ws, LAS unsigned char* lds, int bid, int nb, int tid) {
    constexpr int AP = 136, VP = 264;
    constexpr int OFF_V = 128 * AP * 2, OFF_RS = OFF_V + 128 * VP * 2;
    LAS float* rs = (LAS float*)(lds + OFF_RS);
    const float* RSV = (const float*)(ws + WS_CTL + CTL_RS) + 5 * SEQ;
    const bf16* V = (const bf16*)(ws + WS_VT); const bf16* U = (const bf16*)(ws + WS_U); bf16* G = (bf16*)(ws + WS_YMIX);
    const int w = __builtin_amdgcn_readfirstlane(tid >> 6), lane = tid & 63, fr = lane & 15, fq = lane >> 4;
    u32x4 vst[8];
#define SP_LOADV(un) do { const int n_ = (un) >> 3, g_ = (un) & 7; _Pragma("unroll") for (int it = 0; it < 8; ++it) { const int item = it * NTHR + tid, q = item >> 5, pc = item & 31; \
        vst[it] = *(const u32x4*)(V + (size_t)(n_ * 128 + q) * D + g_ * 256 + pc * 8); } } while (0)
    if (bid < 1024) SP_LOADV(bid);
    for (int unit = bid; unit < 1024; unit += nb) {
        const int n = unit >> 3, g = unit & 7;
        if (tid < 128) rs[tid] = rsq_f(RSV[n * 128 + tid]);
        u32x4 uq[8];
#pragma unroll
        for (int m = 0; m < 8; ++m) uq[m] = *(const u32x4*)(U + (size_t)(n * 128 + m * 16 + fr) * D + g * 256 + w * 32 + 8 * fq);
        const float* wsg = a.in[I_SGWS] + (size_t)g * 128 * 128;
        f32x4 wq[8];
#pragma unroll
        for (int it = 0; it < 8; ++it) wq[it] = *(const f32x4*)(wsg + (it * NTHR + tid) * 4);
        __syncthreads();
#pragma unroll
        for (int it = 0; it < 8; ++it) {
            const int e = (it * NTHR + tid) * 4, p = e >> 7, q = e & 127;
            const f32x4 rv = *(const LAS f32x4*)(rs + q);
            u32x2 o; o.x = cvt_pk_bf16(wq[it][0] * rv[0], wq[it][1] * rv[1]); o.y = cvt_pk_bf16(wq[it][2] * rv[2], wq[it][3] * rv[3]);
            *(LAS u32x2*)(lds + (p * AP + q) * 2) = o;
        }
#pragma unroll
        for (int it = 0; it < 8; ++it) { const int item = it * NTHR + tid, q = item >> 5, pc = item & 31; *(LAS u32x4*)(lds + OFF_V + (q * VP + pc * 8) * 2) = vst[it]; }
        __syncthreads();
        if (unit + nb < 1024) SP_LOADV(unit + nb);
        const LAS unsigned short* Vs = (const LAS unsigned short*)(lds + OFF_V);
        f32x4 acc[8][2];
#pragma unroll
        for (int m = 0; m < 8; ++m)
#pragma unroll
            for (int nf = 0; nf < 2; ++nf) acc[m][nf] = (f32x4){0.f, 0.f, 0.f, 0.f};
#pragma unroll
        for (int ks = 0; ks < 4; ++ks) {
            bf16x8 Bf[2];
#pragma unroll
            for (int nf = 0; nf < 2; ++nf) {
                const LAS unsigned short* vp = Vs + (ks * 32 + fq * 8) * VP + w * 32 + pg8::perm32(nf * 16 + fr);
                u32x4 t; t.x = vp[0] | ((unsigned)vp[VP] << 16); t.y = vp[2 * VP] | ((unsigned)vp[3 * VP] << 16); t.z = vp[4 * VP] | ((unsigned)vp[5 * VP] << 16); t.w = vp[6 * VP] | ((unsigned)vp[7 * VP] << 16);
                __builtin_memcpy(&Bf[nf], &t, 16);
            }
#pragma unroll
            for (int m = 0; m < 8; ++m) {
                const bf16x8 af = *(const LAS bf16x8*)(lds + ((m * 16 + fr) * AP + ks * 32 + fq * 8) * 2);
#pragma unroll
                for (int nf = 0; nf < 2; ++nf) acc[m][nf] = __builtin_amdgcn_mfma_f32_16x16x32_bf16(Bf[nf], af, acc[m][nf], 0, 0, 0);
            }
        }
        {
            const int c0 = g * 256 + w * 32 + 8 * fq;
            const f32x4 sg0 = *(const f32x4*)(a.in[I_SGG] + c0), sg1 = *(const f32x4*)(a.in[I_SGG] + c0 + 4);
#pragma unroll
            for (int m = 0; m < 8; ++m) {
                const int p = m * 16 + fr, t = n * 128 + p;
                const float bsv = a.in[I_SGBS][g * 128 + p];
                const u32x4 uw = uq[m];
                const f32x4 m0 = acc[m][0] * sg0 + bsv, m1 = acc[m][1] * sg1 + bsv;
                u32x4 o; o.x = cvt_pk_bf16(bflo(uw.x) * m0[0], bfhi(uw.x) * m0[1]); o.y = cvt_pk_bf16(bflo(uw.y) * m0[2], bfhi(uw.y) * m0[3]);
                o.z = cvt_pk_bf16(bflo(uw.z) * m1[0], bfhi(uw.z) * m1[1]); o.w = cvt_pk_bf16(bflo(uw.w) * m1[2], bfhi(uw.w) * m1[3]);
                *(u32x4*)(G + (size_t)t * D + c0) = o;
            }
        }
    }
#undef SP_LOADV
}

constexpr int NPHASE = 19;
__global__ void __launch_bounds__(NTHR, 2) fwd(Args a) {
    extern __shared__ __attribute__((aligned(16))) unsigned char lds_raw[];
    LAS unsigned char* lds = (LAS unsigned char*)lds_raw;
    const int tid = threadIdx.x, bid = blockIdx.x, nb = gridDim.x;
    const int lo = a.ph_lo, hi = a.ph_hi;
    volatile LAS unsigned* xbw = (volatile LAS unsigned*)(lds + LDS_BYTES - 16);
    if (tid < 4) xbw[tid] = 0u;
    __syncthreads();
    XcdBarrier bar; bar.bar = (unsigned*)(a.ws + WS_CTL) + 4096; bar.x = 0; bar.st = xbw;
    if (!MK_PER_PHASE) bar = xcd_barrier_post((unsigned*)(a.ws + WS_CTL) + 4096, xbw);
#ifndef PH_MASK
#define PH_MASK 0x7ffffu
#endif
#define IN(k) ((((PH_MASK) >> (k)) & 1u) && lo <= (k) && (k) < hi)
#define SEAM(k) do { if (!MK_PER_PHASE) xcd_barrier(bar); } while (0)
#define PH_VARS unsigned char* ws = fresh_ptr(a.ws); float* mod = (float*)(ws + WS_MOD); \
    const float* mod0l = mod, *mod0c = mod + NMOD * D, *mod1l = mod + 2 * NMOD * D, *mod1c = mod + 3 * NMOD * D; \
    bf16* XN = (bf16*)(ws + WS_XN); bf16* ACT = (bf16*)(ws + WS_ACT); float* XC = (float*)(ws + WS_XC); \
    const bf16* WGU = (const bf16*)(ws + WS_WGU); const bf16* WD = (const bf16*)(ws + WS_WD); float* X = (float*)fresh_ptr((unsigned char*)a.out); \
    bf16* XB = (bf16*)(ws + WS_XB); (void)XB; const float* SW = (const float*)(ws + WS_SW); float* RS = (float*)(ws + WS_CTL + CTL_RS); const bf16* YMIX = (const bf16*)(ws + WS_YMIX); (void)SW; (void)RS; (void)YMIX; \
    (void)mod0l; (void)mod0c; (void)mod1l; (void)mod1c; (void)XN; (void)ACT; (void)XC; (void)WGU; (void)WD; (void)X;

    if (IN(0)) { PH_VARS phase_prologue(a, ws, lds, bid, nb, tid); SEAM(0); }
    if (IN(1)) { PH_VARS phase_filter_fft(a, ws, lds, bid, nb, tid); __syncthreads(); }
    if (IN(2)) { PH_VARS
        {
            f32x4 va[8], vb[8]; int t = a.ncvt_p1 + bid;
            if (t < a.ncvt) { int ja = cvt_job_of(a, t); cvt_issue(a.jobs[ja], t - a.jobs[ja].tile0, tid, va);
                for (;;) {
                    const int t2 = t + nb; int jb = 0; const bool h2 = t2 < a.ncvt;
                    if (h2) { jb = cvt_job_of(a, t2); cvt_issue(a.jobs[jb], t2 - a.jobs[jb].tile0, tid, vb); }
                    cvt_finish(a.jobs[ja], t - a.jobs[ja].tile0, tid, va);
                    if (!h2) break;
                    const int t3 = t2 + nb; const bool h3 = t3 < a.ncvt;
                    if (h3) { ja = cvt_job_of(a, t3); cvt_issue(a.jobs[ja], t3 - a.jobs[ja].tile0, tid, va); }
                    cvt_finish(a.jobs[jb], t2 - a.jobs[jb].tile0, tid, vb);
                    if (!h3) break;
                    t = t3;
                } }
        }
        phase_norm(a.in[I_X], a.in[I_CTX], MTOT, a.in[I_NORMG] + 0 * D, mod0l, mod0c, 0, XN, XC, lds, bid, nb, tid); SEAM(2); }
    if (IN(3)) { PH_VARS pg8::Gemm g{XN, WGU, D, D, D, nullptr, nullptr}; pg8::StaticOrder S; S.init(65, NGU / 256, nb, bid); EpiSwiGLU<false> E{ACT, FF, lds, 0}; pg8::gemm_phase(lds, g, S, E); SEAM(3); }
    if (IN(4)) { PH_VARS
        { pg8::Gemm g{ACT, WD, FF, FF, FF, nullptr, nullptr}; pg8::StaticOrder S; S.init(64, D / 256, nb, bid); EpiRes<true, true, true> E{a.in[I_X], XB, mod0l + 2 * D, RS + 0 * SEQ}; pg8::gemm_phase(lds, g, S, E); }
        { pg8::Gemm g{ACT, WD, FF / 4, FF, FF, nullptr, nullptr}; SplitOrder S{nb, bid}; EpiResAtomic E{XC, mod0c + 2 * D, 0.5f}; pg8::gemm_phase(lds, g, S, E); }
        SEAM(4);
    }
    if (IN(5)) { PH_VARS
        constexpr int NZ = (NZT / 256) * (SEQ / 256), NQ = (SEQ / 256) * (NQK / 256);
        {
            pg8::Gemm g{(const bf16*)(ws + WS_WIN), XB, D, D, D, XB, (const bf16*)(ws + WS_WIN) + (size_t)NZT * D};
            pg8::DualOrder S; S.s0.init(NZT / 256, SEQ / 256, 1, 0); S.s1.init(SEQ / 256, NQK / 256, 1, 0); S.n0 = NZ; S.n1 = NQ; S.G = nb; S.c = bid; S.nE = 0;
            S.et0 = S.et1 = 0; S.epm0 = S.epm1 = 0; S.epn0 = S.epn1 = 0; S.dlo = 4 * nb - 2; S.dn = 2;
            pg8::EpiDual<EpiT<false>, EpiQKV> E{{(bf16*)(ws + WS_ZT), ZTP, RS + 0 * SEQ, SW + SW_IN0, nullptr}, {(bf16*)(ws + WS_QK), (const f32x2*)(ws + WS_ROPE), RS + 0 * SEQ, SW + SW_IN0 + NZT}};
            pg8::gemm_phase(lds, g, S, E);
        }
        if (bid >= nb - 2) {
            ctx_norm_block(XC, a.in[I_NORMG] + 1 * D, mod0c, 3, XN + (size_t)SEQ * D, tid, lds);
            const bf16* WC = (const bf16*)(ws + WS_WINC);
            pg8::Gemm g{WC - (size_t)12 * 256 * D, XN, D, D, D, XN, WC + (size_t)256 * D - (size_t)4 * 256 * D};
            pg8::DualOrder S; S.s0.init(1, 1, 1, 0); S.s1.init(1, 1, 1, 0); S.n0 = 0; S.n1 = 0; S.G = 2; S.c = bid - (nb - 2); S.nE = 2; S.dlo = 0; S.dn = 0;
            S.et0 = 0; S.epm0 = 12; S.epn0 = 64; S.et1 = 1; S.epm1 = 64; S.epn1 = 4;
            pg8::EpiDual<EpiT<false>, EpiQKV> E{{(bf16*)(ws + WS_ZT), ZTP, RS + 0 * SEQ, SW + SW_IN0, nullptr}, {(bf16*)(ws + WS_QK), (const f32x2*)(ws + WS_ROPE), RS + 0 * SEQ, SW + SW_IN0 + NZT}};
            pg8::gemm_phase(lds, g, S, E);
        }
        SEAM(5);
    }
    if (IN(6)) { PH_VARS phase_mixer(a, ws, lds, bid, nb, tid); SEAM(6); }
    if (IN(7)) { PH_VARS phase_transpose(a, ws, lds, bid, nb, tid); SEAM(7); }
    if (IN(8)) { PH_VARS pg8::Gemm g{YMIX, (const bf16*)(ws + WS_WOE), D, D, D, nullptr, nullptr}; pg8::StaticOrder S; S.init(SEQ / 256, D / 256, nb, bid); EpiRes<true, false, false> E{XB, XB, mod0l + 5 * D, RS + 1 * SEQ}; pg8::gemm_phase(lds, g, S, E); SEAM(8); }
    if (IN(9)) { PH_VARS pg8::Gemm g{XB, WGU + (size_t)NGU * D, D, D, D, nullptr, nullptr}; pg8::StaticOrder S; S.init(64, NGU / 256, nb, bid); { pg8::Unit u0; S.next(0, u0); const int rowbase = (u0.pm & ~7) * 256; stage_gateup_tables(RS + 1 * SEQ, SW + SW_GU1, rowbase, lds, tid); EpiSwiGLU<true> E{ACT, FF, lds, rowbase}; pg8::gemm_phase(lds, g, S, E); } SEAM(9); }
    if (IN(10)) { PH_VARS pg8::Gemm g{ACT, WD + (size_t)D * FF, FF, FF, FF, nullptr, nullptr}; pg8::StaticOrder S; S.init(64, D / 256, nb, bid); EpiRes<true, true, false> E{XB, XB, mod0l + 8 * D, RS + 2 * SEQ}; pg8::gemm_phase(lds, g, S, E); SEAM(10); }
    if (IN(11)) { PH_VARS pg8::Gemm g{XB, WGU + 2 * (size_t)NGU * D, D, D, D, nullptr, nullptr}; pg8::StaticOrder S; S.init(64, NGU / 256, nb, bid); { pg8::Unit u0; S.next(0, u0); const int rowbase = (u0.pm & ~7) * 256; stage_gateup_tables(RS + 2 * SEQ, SW + SW_GU2, rowbase, lds, tid); EpiSwiGLU<true> E{ACT, FF, lds, rowbase}; pg8::gemm_phase(lds, g, S, E); } SEAM(11); }
    if (IN(12)) { PH_VARS pg8::Gemm g{ACT, WD + 2 * (size_t)D * FF, FF, FF, FF, nullptr, nullptr}; pg8::StaticOrder S; S.init(64, D / 256, nb, bid); EpiRes<true, true, false> E{XB, XB, mod1l + 2 * D, RS + 3 * SEQ}; pg8::gemm_phase(lds, g, S, E); SEAM(12); }
    if (IN(13)) { PH_VARS
        { pg8::Gemm g{XB, (const bf16*)(ws + WS_WODI), D, D, D, nullptr, nullptr}; pg8::StaticOrder S; S.init(SEQ / 256, 2 * D / 256, nb, bid);
          EpiGeluUV E{(bf16*)(ws + WS_U), (bf16*)(ws + WS_VT), RS + 3 * SEQ, SW + SW_IN1, RS + 5 * SEQ}; pg8::gemm_phase(lds, g, S, E); }
        SEAM(13);
    }
    if (IN(14)) { PH_VARS phase_spatial(a, ws, lds, bid, nb, tid); SEAM(14); }
    if (IN(15)) { PH_VARS pg8::Gemm g{YMIX, (const bf16*)(ws + WS_WODO), D, D, D, nullptr, nullptr}; pg8::StaticOrder S; S.init(SEQ / 256, D / 256, nb, bid); EpiRes<true, false, false> E{XB, XB, mod1l + 5 * D, RS + 4 * SEQ}; pg8::gemm_phase(lds, g, S, E); SEAM(15); }
    if (IN(16)) { PH_VARS pg8::Gemm g{XB, WGU + 3 * (size_t)NGU * D, D, D, D, nullptr, nullptr}; pg8::StaticOrder S; S.init(64, NGU / 256, nb, bid); { pg8::Unit u0; S.next(0, u0); const int rowbase = (u0.pm & ~7) * 256; stage_gateup_tables(RS + 4 * SEQ, SW + SW_GU3, rowbase, lds, tid); EpiSwiGLU<true> E{ACT, FF, lds, rowbase}; pg8::gemm_phase(lds, g, S, E); } SEAM(16); }
    if (IN(17)) { PH_VARS pg8::Gemm g{ACT, WD + 3 * (size_t)D * FF, FF, FF, FF, nullptr, nullptr}; pg8::StaticOrder S; S.init(64, D / 256, nb, bid); EpiRes<false, true, false> E{XB, XB, mod1l + 8 * D, nullptr}; pg8::gemm_phase(lds, g, S, E); SEAM(17); }
    if (IN(18)) { PH_VARS phase_final_norm(XB, X, a.in[I_FING], bid, nb, tid); }
#undef IN
#undef SEAM
}

extern "C" void kernel_launch(void* const* d_in, const int* in_sizes, int n_in, void* d_out, int out_size, void* d_ws, size_t ws_size, hipStream_t stream) {
    static int grid = 0;
    if (grid == 0) {
        if (n_in != 29 || out_size != SEQ * D || ws_size < WS_END) { fprintf(stderr, "kernel_launch: unexpected problem (n_in %d, out %d, ws %zu < %zu)\n", n_in, out_size, ws_size, (size_t)WS_END); grid = -1; return; }
        int dev = 0, cus = 0;
        if (hipGetDevice(&dev) != hipSuccess || hipDeviceGetAttribute(&cus, hipDeviceAttributeMultiprocessorCount, dev) != hipSuccess) { grid = -1; return; }
        if (hipFuncSetAttribute((const void*)fwd, hipFuncAttributeMaxDynamicSharedMemorySize, LDS_BYTES) != hipSuccess) { fprintf(stderr, "kernel_launch: hipFuncSetAttribute failed\n"); grid = -1; return; }
        int per_cu = 0;
        if (hipOccupancyMaxActiveBlocksPerMultiprocessor(&per_cu, (const void*)fwd, NTHR, LDS_BYTES) != hipSuccess || per_cu < 1) fprintf(stderr, "kernel_launch: occupancy query says %d\n", per_cu);
        (void)hipGetLastError();
        grid = cus;
    }
    if (grid < 0) return;
    (void)hipMemsetAsync((char*)d_ws + WS_CTL, 0, CTL_ZERO_BYTES, stream);
    Args a{};
    for (int i = 0; i < 29; ++i) a.in[i] = (const float*)d_in[i];
    a.out = (float*)d_out; a.ws = (unsigned char*)d_ws;
    unsigned char* ws = (unsigned char*)d_ws;
    int nj = 0, tiles = 0;
    auto add = [&](const float* src, bf16* dst, int K, int N, int kind, const float* shift, float* sw, const float* fg, const float* fs, bf16* dst2) {
        a.jobs[nj].src = src; a.jobs[nj].dst = dst; a.jobs[nj].shift = shift; a.jobs[nj].sw = sw; a.jobs[nj].fg = fg; a.jobs[nj].fs = fs; a.jobs[nj].dst2 = dst2;
        a.jobs[nj].K = K; a.jobs[nj].N = N; a.jobs[nj].kind = kind; a.jobs[nj].tile0 = tiles; tiles += (K / 128) * (N / 128); ++nj; };
    const float* modp = (const float*)(ws + WS_MOD); const float* m0l = modp; const float* m1l = modp + 2 * NMOD * D;
    const float* ng = a.in[I_NORMG];
    float* SWp = (float*)(ws + WS_SW);
    auto wgu = [&](int f) { return (bf16*)(ws + WS_WGU + f * WGU_SZ); };
    add(a.in[I_WG], wgu(0), D, FF, 1, nullptr, nullptr, nullptr, nullptr, nullptr); add(a.in[I_WU], wgu(0), D, FF, 2, nullptr, nullptr, nullptr, nullptr, nullptr);
    for (int f = 0; f < 4; ++f) add(a.in[I_WD] + (size_t)f * FF * D, (bf16*)(ws + WS_WD + f * WD_SZ), FF, D, 0, nullptr, nullptr, nullptr, nullptr, nullptr);
    add(a.in[I_EVWOUT], (bf16*)(ws + WS_WOE), D, D, 0, nullptr, nullptr, nullptr, nullptr, nullptr);
    add(a.in[I_ODWOUT], (bf16*)(ws + WS_WODO), D, D, 0, nullptr, nullptr, nullptr, nullptr, nullptr);
    a.ncvt_early = tiles;
    add(a.in[I_EVWIN], (bf16*)(ws + WS_WIN), D, INEV, 3, m0l + 3 * D, SWp + SW_IN0, ng + 1 * D, m0l + 4 * D, (bf16*)(ws + WS_WINC));
    { const float* sh[4] = {nullptr, m0l + 6 * D, m1l + 0 * D, m1l + 6 * D}; const float* fgv[4] = {nullptr, ng + 2 * D, ng + 3 * D, ng + 5 * D}; const float* fsv[4] = {nullptr, m0l + 7 * D, m1l + 1 * D, m1l + 7 * D};
      const int so[4] = {0, SW_GU1, SW_GU2, SW_GU3};
      for (int f = 1; f < 4; ++f) { add(a.in[I_WG] + (size_t)f * D * FF, wgu(f), D, FF, 1, sh[f], SWp + so[f], fgv[f], fsv[f], nullptr); add(a.in[I_WU] + (size_t)f * D * FF, wgu(f), D, FF, 2, sh[f], SWp + so[f], fgv[f], fsv[f], nullptr);
                                    if (f == 1) a.ncvt_p1 = tiles; } }
    add(a.in[I_ODWIN], (bf16*)(ws + WS_WODI), D, 2 * D, 0, m1l + 3 * D, SWp + SW_IN1, ng + 4 * D, m1l + 4 * D, nullptr);
    a.ncvt = tiles;
#if MK_PER_PHASE
    for (int ph = 0; ph < NPHASE; ++ph) {
        a.ph_lo = ph; a.ph_hi = ph + 1;
        hipLaunchKernelGGL(fwd, dim3(grid), dim3(NTHR), LDS_BYTES, stream, a);
    }
#else
    a.ph_lo = 0; a.ph_hi = NPHASE;
    hipLaunchKernelGGL(fwd, dim3(grid), dim3(NTHR), LDS_BYTES, stream, a);
#endif
    const hipError_t le = hipPeekAtLastError();
    if (le != hipSuccess) fprintf(stderr, "kernel_launch: launch failed: %s\n", hipGetErrorName(le));
}
#endif
```

```cpp
#include <hip/hip_runtime.h>
#include <cstdio>
#include <cstdint>

#ifndef MK_PER_PHASE
#define MK_PER_PHASE 0
#endif

#define HD __host__ __device__ __forceinline__
#define DEV __device__ __forceinline__
#define LAS __attribute__((address_space(3)))
typedef unsigned short bf16;
typedef short bf16x8 __attribute__((ext_vector_type(8)));
typedef float f32x4 __attribute__((ext_vector_type(4)));
typedef float f32x2 __attribute__((ext_vector_type(2)));
typedef unsigned u32x4 __attribute__((ext_vector_type(4)));
typedef unsigned u32x2 __attribute__((ext_vector_type(2)));

constexpr int D = 2048, SEQ = 16384, NCTX = 256, MTOT = SEQ + NCTX, FF = 5632, NGU = 2 * FF;
constexpr int HYW = 1024, HYIN = 3072, INEV = 4608, NQK = 1280, NZT = 3328, ZTP = MTOT;
constexpr int NMOD = 9, NH = 8, HDIM = 128;
constexpr float EPS = 1e-6f;
constexpr int NTHR = 512;

constexpr size_t MiB = 1u << 20;
constexpr size_t WS_CTL = 0, CTL_ZERO_BYTES = 1 * MiB;
constexpr size_t WS_MOD = 1 * MiB;
constexpr size_t WS_ROPE = 1 * MiB + 512 * 1024;
constexpr size_t WS_SW = WS_CTL + 512 * 1024;
constexpr size_t WS_XC = 4 * MiB;
constexpr size_t WS_WGU = 8 * MiB;
constexpr size_t WGU_SZ = (size_t)NGU * D * 2;
constexpr size_t WS_WD = WS_WGU + 4 * WGU_SZ;
constexpr size_t WD_SZ = (size_t)D * FF * 2;
constexpr size_t WS_WIN = WS_WD + 4 * WD_SZ;
constexpr size_t WS_WOE = WS_WIN + (size_t)INEV * D * 2;
constexpr size_t WS_WODI = WS_WOE + (size_t)D * D * 2;
constexpr size_t WS_WODO = WS_WODI + (size_t)2 * D * D * 2;
constexpr size_t WS_XN = WS_WODO + (size_t)D * D * 2;
constexpr size_t WS_ACT = WS_XN + (size_t)MTOT * D * 2;
constexpr size_t ACT_SZ = (size_t)MTOT * FF * 2;
constexpr size_t WS_ZT = WS_ACT;
constexpr size_t WS_QK = WS_ACT + 106 * MiB;
constexpr size_t WS_U = WS_ACT;
constexpr size_t WS_VT = WS_ACT + 64 * MiB;
constexpr size_t WS_KT = (WS_ACT + ACT_SZ + MiB - 1) / MiB * MiB;
constexpr size_t WS_YHT = WS_KT;
constexpr size_t WS_YMIX = WS_KT + 32 * MiB;
constexpr int KSP = 8200;
constexpr size_t WS_KS = WS_KT + 128 * MiB;
constexpr size_t WS_WINC = 6 * MiB;
constexpr size_t WS_XB = WS_KS + 129 * MiB;
constexpr size_t WS_END = WS_XB + 64 * MiB;
static_assert(WS_ZT + (size_t)NZT * ZTP * 2 <= WS_QK && WS_QK + (size_t)MTOT * NQK * 2 <= WS_ACT + ACT_SZ, "overlay map");

constexpr int SW_IN0 = 0, SW_GU1 = INEV, SW_GU2 = INEV + NGU, SW_GU3 = INEV + 2 * NGU, SW_IN1 = INEV + 3 * NGU, SW_TOTAL = INEV + 3 * NGU + 2 * D;
constexpr size_t CTL_RS = 64 * 1024;
constexpr int LDS_BYTES = 160 * 1024 - 512;

DEV unsigned cvt_pk_bf16(float lo, float hi) { unsigned r; asm volatile("v_cvt_pk_bf16_f32 %0, %1, %2" : "=v"(r) : "v"(lo), "v"(hi)); return r; }
DEV float bf2f(unsigned short b) { return __uint_as_float(((unsigned)b) << 16); }
DEV float bflo(unsigned w) { return __uint_as_float(w << 16); }
DEV float bfhi(unsigned w) { return __uint_as_float(w & 0xffff0000u); }
DEV float wave_sum(float v) {
#pragma unroll
    for (int o = 32; o >= 1; o >>= 1) v += __shfl_xor(v, o);
    return v;
}
DEV float wave_max(float v) {
#pragma unroll
    for (int o = 32; o >= 1; o >>= 1) v = fmaxf(v, __shfl_xor(v, o));
    return v;
}
DEV f32x2 gelu_tanh_pk(f32x2 x) {
    f32x2 t = x * x; t = t * 0.044715f + 1.0f; t = t * x;
    const f32x2 a = t * (-2.88539008178f * 0.7978845608f);
    f32x2 e; e.x = __builtin_amdgcn_exp2f(a.x); e.y = __builtin_amdgcn_exp2f(a.y);
    const f32x2 d = e + 1.0f;
    f32x2 r; r.x = __builtin_amdgcn_rcpf(d.x); r.y = __builtin_amdgcn_rcpf(d.y);
    return x * r;
}
DEV unsigned swiglu_pk(f32x2 g, f32x2 u) {
    const f32x2 t = g * -1.44269504089f;
    f32x2 e; e.x = __builtin_amdgcn_exp2f(t.x); e.y = __builtin_amdgcn_exp2f(t.y);
    const f32x2 d = e + 1.0f;
    f32x2 r; r.x = __builtin_amdgcn_rcpf(d.x); r.y = __builtin_amdgcn_rcpf(d.y);
    const f32x2 o = (g * u) * r;
    return cvt_pk_bf16(o.x, o.y);
}
DEV float silu_f(float g) { return g * __builtin_amdgcn_rcpf(1.0f + __builtin_amdgcn_exp2f(-1.44269504089f * g)); }
DEV float gelu_tanh_f(float x) { const float u = 0.7978845608f * (x + 0.044715f * x * x * x); return x * __builtin_amdgcn_rcpf(1.0f + __builtin_amdgcn_exp2f(-2.88539008178f * u)); }

#define XB_TMO      128
#define XB_XCNT(j)  (256  + 64 * (j))
#define XB_XSUB(j)  (1280 + 64 * (j))
#define XB_XGEN(j)  (2304 + 64 * (j))
#define XB_TOP      3328
#define XB_TOPGEN   3392
#define XCD_BAR_WORDS 3456
#define XB_SPIN_CAP (1u << 18)

__device__ __forceinline__ unsigned xb_ld(unsigned* p)              { return __hip_atomic_load(p, __ATOMIC_RELAXED, __HIP_MEMORY_SCOPE_AGENT); }
__device__ __forceinline__ unsigned xb_add(unsigned* p, unsigned v) { return __hip_atomic_fetch_add(p, v, __ATOMIC_RELAXED, __HIP_MEMORY_SCOPE_AGENT); }
__device__ __forceinline__ unsigned xb_xcc_id() { return (unsigned)__builtin_amdgcn_s_getreg((3 << 11) | 20) & 0xFu; }
#define XB_SPIN(cond, bar) do { unsigned _sp = 0; while (cond) { __builtin_amdgcn_s_sleep(1); \
    if ((++_sp & 255u) == 0u) { if (xb_ld(&(bar)[XB_TMO])) break; if (_sp > XB_SPIN_CAP) { atomicAdd(&(bar)[XB_TMO], 1u); break; } } } } while (0)

struct XcdBarrier {
    unsigned* bar; unsigned x;
    volatile LAS unsigned* st;
};

__device__ __forceinline__ XcdBarrier xcd_barrier_post(unsigned* bar, volatile LAS unsigned* st) {
    XcdBarrier b; b.bar = bar; b.x = xb_xcc_id(); b.st = st;
    if (threadIdx.x == 0) (void)xb_add(&bar[XB_XCNT(b.x)], 1u);
    return b;
}
__device__ __forceinline__ void xcd_barrier_complete(unsigned* bar, unsigned x, unsigned& nloc, unsigned& nx) {
    const unsigned G = gridDim.x * gridDim.y * gridDim.z;
    unsigned sum, cnt, mine, sp = 0u;
    for (;;) {
        sum = 0u; cnt = 0u; mine = 0u;
#pragma unroll
        for (unsigned j = 0; j < 16; ++j) { const unsigned c = xb_ld(&bar[XB_XCNT(j)]); sum += c; cnt += (c > 0u) ? 1u : 0u; mine = (j == x) ? c : mine; }
        if (sum == G) break;
        __builtin_amdgcn_s_sleep(1);
        if ((++sp & 255u) == 0u) { if (xb_ld(&bar[XB_TMO])) break; if (sp > XB_SPIN_CAP) { atomicAdd(&bar[XB_TMO], 1u); break; } }
    }
    nloc = mine > 0u ? mine : 1u; nx = cnt > 0u ? cnt : 1u;
}

__device__ __forceinline__ void xcd_barrier(const XcdBarrier& b) {
    asm volatile("s_waitcnt vmcnt(0)" ::: "memory");
    __syncthreads();
    if (threadIdx.x == 0) {
        unsigned* bar = b.bar;
        __builtin_amdgcn_s_waitcnt(0);
        unsigned nloc = b.st[0], nx = b.st[1];
        if (nloc == 0u) { xcd_barrier_complete(bar, b.x, nloc, nx); b.st[0] = nloc; b.st[1] = nx; }
        const unsigned old = xb_add(&bar[XB_XSUB(b.x)], 1u);
        const unsigned gen = old / nloc;
        if (old + 1u == (gen + 1u) * nloc) {
            __builtin_amdgcn_fence(__ATOMIC_RELEASE, "agent");
            asm volatile("s_waitcnt vmcnt(0)" ::: "memory");
            const unsigned og = xb_add(&bar[XB_TOP], 1u);
            const unsigned tg = og / nx;
            if (og + 1u == (tg + 1u) * nx) xb_add(&bar[XB_TOPGEN], 1u);
            else XB_SPIN(xb_ld(&bar[XB_TOPGEN]) == tg, bar);
            __builtin_amdgcn_fence(__ATOMIC_ACQUIRE, "agent");
            xb_add(&bar[XB_XGEN(b.x)], 1u);
            asm volatile("s_waitcnt vmcnt(0)" ::: "memory");
        } else {
            XB_SPIN(xb_ld(&bar[XB_XGEN(b.x)]) == gen, bar);
            __builtin_amdgcn_fence(__ATOMIC_ACQUIRE, "agent");
            asm volatile("s_waitcnt vmcnt(0)" ::: "memory");
        }
    }
    __syncthreads();
}


namespace pg8 {
constexpr int BM = 256, BK = 64, HALF = 128, HTB = HALF * BK * 2, STAGE_BYTES = 8 * HTB, NXCD = 8, WGM = 8;
HD int lds_byte(int r, int c) { const int st = (r >> 4) * 2 + (c >> 5), rr = r & 15, cc = c & 31, ob = rr * 64 + cc * 2; return st * 1024 + (ob ^ (((ob >> 9) & 1) << 5)); }
HD void stage_rc(int b, int& R, int& C) { const int st = b / 1024, sb = b % 1024, swz = sb ^ (((sb >> 9) & 1) << 5); R = (st >> 1) * 16 + swz / 64; C = (st & 1) * 32 + (swz % 64) / 2; }
HD int perm32(int rho) { const int n = rho >> 4, i = rho & 15; return 8 * (i >> 2) + 4 * n + (i & 3); }
struct Unit { int pm, pn, ko, type; };
struct Gemm { const bf16* A; const bf16* Bt; int K, lda, ldb; const bf16* A2; const bf16* Bt2; };
struct StaticOrder {
    int nM, nN, nwg, G, c, nX, pmx, pnx0;
    HD void init(int nM_, int nN_, int G_, int c_, int nX_ = 0, int pmx_ = 0, int pnx0_ = 0) { nM = nM_; nN = nN_; nwg = nM * nN; G = G_; c = c_; nX = nX_; pmx = pmx_; pnx0 = pnx0_; }
    HD bool next(int i, Unit& u) const { return map((long)i * G + c, u); }
    HD bool map(long Lq, Unit& u) const {
        if (Lq >= nwg + nX) return false;
        u.ko = 0; u.type = 0; if (Lq >= nwg) { u.pm = pmx; u.pn = pnx0 + (int)(Lq - nwg); return true; }
        int wgid = (int)Lq; { const int q = nwg / NXCD, r = nwg % NXCD, xcd = wgid % NXCD, off = wgid / NXCD; wgid = (xcd < r ? xcd * (q + 1) : r * (q + 1) + (xcd - r) * q) + off; }
        const int nig = WGM * nN, gid = wgid / nig, fm = gid * WGM, gsz = (nM - fm) < WGM ? (nM - fm) : WGM;
        u.pm = fm + ((wgid % nig) % gsz); u.pn = (wgid % nig) / gsz; return true;
    }
    DEV void a_ready(const Unit&) const {}
    DEV void done(const Unit&) const {}
};
struct DualOrder {
    StaticOrder s0, s1; int n0, n1, G, c, nE, et0, epm0, epn0, et1, epm1, epn1;
    int dlo, dn;
    HD bool next(int i, Unit& u) const {
        long L = (long)i * G + c;
        if (L >= dlo && L < dlo + dn) return false;
        if (L >= n0 + n1 && L < n0 + n1 + dn) L = dlo + (L - n0 - n1);
        if (L < n0) { s0.map(L, u); u.type = 0; return true; }
        if (L < n0 + n1) { s1.map(L - n0, u); u.type = 1; return true; }
        const int e = (int)(L - n0 - n1 - dn); if (e < 0 || e >= nE) return false;
        u.ko = 0; u.type = e ? et1 : et0; u.pm = e ? epm1 : epm0; u.pn = e ? epn1 : epn0;
#if defined(__HIP_DEVICE_COMPILE__)
        u.type = __builtin_amdgcn_readfirstlane(u.type); u.pm = __builtin_amdgcn_readfirstlane(u.pm); u.pn = __builtin_amdgcn_readfirstlane(u.pn);
#endif
        return true;
    }
    DEV void a_ready(const Unit&) const {}
    DEV void done(const Unit&) const {}
};
template <class E0, class E1> struct EpiDual {
    static constexpr bool PERM = E0::PERM; static_assert(E0::PERM == E1::PERM, "EpiDual: both epilogues must stage B the same way");
    E0 e0; E1 e1;
    DEV void operator()(const f32x4 (&acc)[2][2][4][2], const Unit& u, int wr, int wc, int fr, int fq) const { if (u.type == 0) e0(acc, u, wr, wc, fr, fq); else e1(acc, u, wr, wc, fr, fq); }
};

template <class Epi, class Sched, bool ALIGN_EPI = true, bool SP2 = true>
DEV void gemm_phase(LAS unsigned char* lds, const Gemm g, const Sched& S, const Epi& E) {
    const int tid = threadIdx.x, wid = __builtin_amdgcn_readfirstlane(tid >> 6), lane = tid & 63, wr = wid >> 2, wc = wid & 3, fr = lane & 15, fq = lane >> 4;
    const int K = g.K, nt = K / BK;
    unsigned voffA[2], voffB[2];
#pragma unroll
    for (int i = 0; i < 2; ++i) { int R, C; stage_rc(tid * 16 + i * 8192, R, C); const int Rb = Epi::PERM ? ((R & ~31) + perm32(R & 31)) : R;
        voffA[i] = (unsigned)(R * g.lda + C) * 2u; voffB[i] = (unsigned)(Rb * g.ldb + C) * 2u; }
    const size_t kstep = (size_t)(BK * 2);
    const size_t hstepA = (size_t)HALF * g.lda * 2, hstepB = (size_t)HALF * g.ldb * 2;
    const size_t tstepA = 2 * hstepA, tstepB = 2 * hstepB;
    const unsigned ldsw = (unsigned)wid * 1024u;
    const int aoff = lds_byte(wr * 64 + fr, fq * 8), boff = lds_byte(wc * 32 + fr, fq * 8);
#define PG8_SA(b, h) (((b) * 2 + (h)) * HTB)
#define PG8_SB(b, h) ((4 + (b) * 2 + (h)) * HTB)
#define PG8_STAGE(bufoff, gbase, voff) do { _Pragma("unroll") for (int _i = 0; _i < 2; ++_i) \
        __builtin_amdgcn_global_load_lds((const unsigned*)((const char*)(gbase) + (voff)[_i]), (LAS unsigned*)(lds + (bufoff) + ldsw + _i * 8192), 16, 0, 0); } while (0)
#define PG8_LDA(dst, b, h) do { _Pragma("unroll") for (int m = 0; m < 4; ++m) _Pragma("unroll") for (int k = 0; k < 2; ++k) dst[m][k] = *(const LAS bf16x8*)(lds + PG8_SA(b, h) + aoff + m * 2048 + k * 1024); } while (0)
#define PG8_LDB(dst, b, h) do { _Pragma("unroll") for (int n = 0; n < 2; ++n) _Pragma("unroll") for (int k = 0; k < 2; ++k) dst[n][k] = *(const LAS bf16x8*)(lds + PG8_SB(b, h) + boff + n * 2048 + k * 1024); } while (0)
#define PG8_MMA(ai, bj, At, Bt) do { __builtin_amdgcn_s_setprio(1); _Pragma("unroll") for (int m = 0; m < 4; ++m) _Pragma("unroll") for (int n = 0; n < 2; ++n) _Pragma("unroll") for (int k = 0; k < 2; ++k) \
        acc[ai][bj][m][n] = __builtin_amdgcn_mfma_f32_16x16x32_bf16(Bt[n][k], At[m][k], acc[ai][bj][m][n], 0, 0, 0); __builtin_amdgcn_s_setprio(0); } while (0)
#define PG8_WAIT_V(n) asm volatile("s_waitcnt vmcnt(" #n ")" ::: "memory")
#define PG8_WAIT_L(n) asm volatile("s_waitcnt lgkmcnt(" #n ")" ::: "memory")
#define PG8_BAR __builtin_amdgcn_s_barrier()
#define PG8_SCHED __builtin_amdgcn_sched_barrier(0)
    Unit cur, nxt; int ui = 0;
    if (!S.next(0, cur)) return;
    f32x4 acc[2][2][4][2];
#pragma unroll
    for (int a = 0; a < 2; ++a)
#pragma unroll
        for (int b = 0; b < 2; ++b)
#pragma unroll
            for (int m = 0; m < 4; ++m)
#pragma unroll
                for (int n = 0; n < 2; ++n) acc[a][b][m][n] = (f32x4){0.f, 0.f, 0.f, 0.f};
    bf16x8 At[4][2], B0[2][2], B1[2][2];
    const char* cA = (const char*)(cur.type ? g.A2 : g.A) + (size_t)cur.pm * tstepA + (size_t)cur.ko * 2; const char* cB = (const char*)(cur.type ? g.Bt2 : g.Bt) + (size_t)cur.pn * tstepB + (size_t)cur.ko * 2;
    S.a_ready(cur);
    if constexpr (SP2) {
        PG8_STAGE(PG8_SB(0, 0), cB, voffB); PG8_STAGE(PG8_SB(0, 1), cB + hstepB, voffB); PG8_STAGE(PG8_SA(0, 0), cA, voffA); PG8_STAGE(PG8_SA(0, 1), cA + hstepA, voffA);
        if (wr == 1) PG8_BAR;
        PG8_WAIT_V(2); PG8_BAR;
        PG8_STAGE(PG8_SB(1, 0), cB + kstep, voffB); PG8_STAGE(PG8_SA(1, 0), cA + kstep, voffA); PG8_STAGE(PG8_SB(1, 1), cB + hstepB + kstep, voffB);
        PG8_WAIT_V(6); PG8_BAR;
    }
    for (;;) {
        const bool has_next = S.next(ui + 1, nxt);
        const char* nA = has_next ? (const char*)(nxt.type ? g.A2 : g.A) + (size_t)nxt.pm * tstepA + (size_t)nxt.ko * 2 : cA; const char* nB = has_next ? (const char*)(nxt.type ? g.Bt2 : g.Bt) + (size_t)nxt.pn * tstepB + (size_t)nxt.ko * 2 : cB;
        for (int t = 0; t < nt; t += 2) {
            const bool last = (t == nt - 2);
            const char* a1 = cA + (size_t)(t + 1) * kstep;
            const char* a2 = last ? nA : cA + (size_t)(t + 2) * kstep; const char* b2 = last ? nB : cB + (size_t)(t + 2) * kstep;
            const char* a3 = a2 + kstep; const char* b3 = b2 + kstep;
            if (last && has_next) S.a_ready(nxt);
            if constexpr (SP2) {
            PG8_LDB(B0, 0, 0); PG8_LDB(B1, 0, 1); PG8_SCHED; PG8_LDA(At, 0, 0); PG8_STAGE(PG8_SA(1, 1), a1 + hstepA, voffA);
            PG8_WAIT_V(8); PG8_WAIT_L(0); PG8_BAR; PG8_MMA(0, 0, At, B0); PG8_MMA(0, 1, At, B1); PG8_BAR; PG8_SCHED;
            PG8_LDA(At, 0, 1); PG8_STAGE(PG8_SB(0, 0), b2, voffB); PG8_STAGE(PG8_SB(0, 1), b2 + hstepB, voffB); PG8_STAGE(PG8_SA(0, 0), a2, voffA);
            PG8_WAIT_V(8); PG8_WAIT_L(0); PG8_BAR; PG8_MMA(1, 0, At, B0); PG8_MMA(1, 1, At, B1); PG8_BAR; PG8_SCHED;
            PG8_LDB(B0, 1, 0); PG8_LDB(B1, 1, 1); PG8_SCHED; PG8_LDA(At, 1, 0); PG8_STAGE(PG8_SA(0, 1), a2 + hstepA, voffA);
            PG8_WAIT_V(8); PG8_WAIT_L(0); PG8_BAR; PG8_MMA(0, 0, At, B0); PG8_MMA(0, 1, At, B1); PG8_BAR; PG8_SCHED;
            PG8_LDA(At, 1, 1); PG8_STAGE(PG8_SB(1, 0), b3, voffB); PG8_STAGE(PG8_SB(1, 1), b3 + hstepB, voffB); PG8_STAGE(PG8_SA(1, 0), a3, voffA);
            PG8_WAIT_V(8); PG8_WAIT_L(0); PG8_BAR; PG8_MMA(1, 0, At, B0); PG8_MMA(1, 1, At, B1); PG8_BAR; PG8_SCHED;
            }
        }
        if constexpr (ALIGN_EPI) { if (wr == 0) PG8_BAR; }
        E(acc, cur, wr, wc, fr, fq); S.done(cur);
        if (!has_next) break;
#pragma unroll
        for (int a = 0; a < 2; ++a)
#pragma unroll
            for (int b = 0; b < 2; ++b)
#pragma unroll
                for (int m = 0; m < 4; ++m)
#pragma unroll
                    for (int n = 0; n < 2; ++n) acc[a][b][m][n] = (f32x4){0.f, 0.f, 0.f, 0.f};
        cur = nxt; cA = nA; cB = nB; ++ui;
        if constexpr (ALIGN_EPI) { if (wr == 1) PG8_BAR; }
    }
    PG8_WAIT_V(0);
    if constexpr (!ALIGN_EPI) { if (wr == 0) PG8_BAR; }
    PG8_BAR;
#undef PG8_SA
#undef PG8_SB
#undef PG8_STAGE
#undef PG8_LDA
#undef PG8_LDB
#undef PG8_MMA
#undef PG8_WAIT_V
#undef PG8_WAIT_L
#undef PG8_BAR
#undef PG8_SCHED
}
}
using pg8::Unit;
typedef f32x4 Acc[2][2][4][2];

DEV float rsq_f(float ss) { return __builtin_amdgcn_rsqf(ss * (1.0f / D) + EPS); }
DEV float rstd_of(const float* rs, int row) { return rsq_f(rs[row]); }
constexpr int LDS_RT = 131072, LDS_SWT = 131072 + 8192;
DEV void stage_gateup_tables(const float* rs, const float* sw, int rowbase, LAS unsigned char* lds, int tid) {
    LAS float* rt = (LAS float*)(lds + LDS_RT); LAS unsigned* swt = (LAS unsigned*)(lds + LDS_SWT);
    for (int i = tid; i < 2048; i += NTHR) rt[i] = 1.0f / sqrtf(rs[rowbase + i] * (1.0f / D) + EPS);
    for (int i = tid; i < NGU / 2; i += NTHR) { const f32x2 v = *(const f32x2*)(sw + 2 * i); swt[i] = cvt_pk_bf16(v.x, v.y); }
    __syncthreads();
}
template <bool SCALE> struct EpiSwiGLU {
    static constexpr bool PERM = true;
    bf16* O; int ldc; LAS unsigned char* lds; int rowbase;
    DEV void operator()(const Acc& acc, const Unit& u, int wr, int wc, int fr, int fq) const {
        const int row0 = u.pm * 256 + wr * 64 + fr, cl = wc * 32 + 8 * fq, col0 = u.pn * 128 + cl;
        f32x4 sg0 = (f32x4){0.f, 0.f, 0.f, 0.f}, sg1 = sg0, su0 = sg0, su1 = sg0;
        if (SCALE) {
            const u32x4 gw = *(const LAS u32x4*)(lds + LDS_SWT + (u.pn * 256 + cl) * 2), uw = *(const LAS u32x4*)(lds + LDS_SWT + (u.pn * 256 + 128 + cl) * 2);
            sg0 = (f32x4){bflo(gw.x), bfhi(gw.x), bflo(gw.y), bfhi(gw.y)}; sg1 = (f32x4){bflo(gw.z), bfhi(gw.z), bflo(gw.w), bfhi(gw.w)};
            su0 = (f32x4){bflo(uw.x), bfhi(uw.x), bflo(uw.y), bfhi(uw.y)}; su1 = (f32x4){bflo(uw.z), bfhi(uw.z), bflo(uw.w), bfhi(uw.w)};
        }
        const LAS float* rt = (const LAS float*)(lds + LDS_RT) + (row0 - rowbase);
#pragma unroll
        for (int ai = 0; ai < 2; ++ai)
#pragma unroll
            for (int m = 0; m < 4; ++m) {
                const int row = row0 + ai * 128 + m * 16;
                bf16* rowp = O + (size_t)row * ldc + col0;
                const float r = SCALE ? rt[ai * 128 + m * 16] : 1.0f;
                const f32x4 g0 = acc[ai][0][m][0] * r + sg0, g1 = acc[ai][0][m][1] * r + sg1, u0 = acc[ai][1][m][0] * r + su0, u1 = acc[ai][1][m][1] * r + su1;
                u32x4 w;
                w.x = swiglu_pk((f32x2){g0[0], g0[1]}, (f32x2){u0[0], u0[1]}); w.y = swiglu_pk((f32x2){g0[2], g0[3]}, (f32x2){u0[2], u0[3]});
                w.z = swiglu_pk((f32x2){g1[0], g1[1]}, (f32x2){u1[0], u1[1]}); w.w = swiglu_pk((f32x2){g1[2], g1[3]}, (f32x2){u1[2], u1[3]});
                *(u32x4*)rowp = w;
            }
    }
};
template <bool FUSE, bool HALFC, bool BASEF32> struct EpiRes {
    static constexpr bool PERM = true;
    static constexpr float cmul = HALFC ? 0.5f : 1.0f;
    static constexpr int PF = BASEF32 ? 2 : 3;
    const void* base; bf16* out; const float* coef; float* rs;
    struct Row { u32x4 w[BASEF32 ? 2 : 1]; };
    DEV Row ldr(size_t off) const {
        Row r;
        if (BASEF32) { r.w[0] = *(const u32x4*)((const float*)base + off); r.w[BASEF32 ? 1 : 0] = *(const u32x4*)((const float*)base + off + 4); }
        else r.w[0] = *(const u32x4*)((const bf16*)base + off);
        return r;
    }
    DEV void unpack(const Row& r, f32x4& lo, f32x4& hi) const {
        if (BASEF32) { const u32x4 a = r.w[0], b = r.w[BASEF32 ? 1 : 0]; lo = (f32x4){__uint_as_float(a.x), __uint_as_float(a.y), __uint_as_float(a.z), __uint_as_float(a.w)}; hi = (f32x4){__uint_as_float(b.x), __uint_as_float(b.y), __uint_as_float(b.z), __uint_as_float(b.w)}; }
        else { const u32x4 w = r.w[0]; lo = (f32x4){bflo(w.x), bfhi(w.x), bflo(w.y), bfhi(w.y)}; hi = (f32x4){bflo(w.z), bfhi(w.z), bflo(w.w), bfhi(w.w)}; }
    }
    DEV void operator()(const Acc& acc, const Unit& u, int wr, int wc, int fr, int fq) const {
        const int row0 = u.pm * 256 + wr * 64 + fr, col0 = u.pn * 256 + wc * 32 + 8 * fq;
        f32x4 cv[2][2];
#pragma unroll
        for (int bj = 0; bj < 2; ++bj)
#pragma unroll
            for (int n = 0; n < 2; ++n) cv[bj][n] = *(const f32x4*)(coef + col0 + bj * 128 + 4 * n) * cmul;
        Row ring[PF][2];
#pragma unroll
        for (int gp = 0; gp < PF; ++gp)
#pragma unroll
            for (int bj = 0; bj < 2; ++bj) ring[gp][bj] = ldr((size_t)(row0 + (gp >> 2) * 128 + (gp & 3) * 16) * D + col0 + bj * 128);
#pragma unroll
        for (int gi = 0; gi < 8; ++gi) {
            const int ai = gi >> 2, m = gi & 3;
            const int row = row0 + ai * 128 + m * 16;
            const size_t off = (size_t)row * D + col0;
            float ss = 0.f;
#pragma unroll
            for (int bj = 0; bj < 2; ++bj) {
                f32x4 b0, b1; unpack(ring[gi % PF][bj], b0, b1);
                const f32x4 o0 = b0 + cv[bj][0] * acc[ai][bj][m][0], o1 = b1 + cv[bj][1] * acc[ai][bj][m][1];
                u32x4 xo; xo.x = cvt_pk_bf16(o0[0], o0[1]); xo.y = cvt_pk_bf16(o0[2], o0[3]); xo.z = cvt_pk_bf16(o1[0], o1[1]); xo.w = cvt_pk_bf16(o1[2], o1[3]);
                *(u32x4*)(out + off + bj * 128) = xo;
                if (FUSE) {
                    const float q0 = bflo(xo.x), q1 = bfhi(xo.x), q2 = bflo(xo.y), q3 = bfhi(xo.y), q4 = bflo(xo.z), q5 = bfhi(xo.z), q6 = bflo(xo.w), q7 = bfhi(xo.w);
                    ss += (q0 * q0 + q1 * q1) + (q2 * q2 + q3 * q3) + (q4 * q4 + q5 * q5) + (q6 * q6 + q7 * q7); }
            }
            if (FUSE) { ss += __shfl_xor(ss, 16); ss += __shfl_xor(ss, 32); if (fq == 0) atomicAdd(rs + row, ss); }
            if (gi + PF < 8) { const int rown = row0 + ((gi + PF) >> 2) * 128 + ((gi + PF) & 3) * 16;
#pragma unroll
                for (int bj = 0; bj < 2; ++bj) ring[gi % PF][bj] = ldr((size_t)rown * D + col0 + bj * 128); }
        }
    }
};
struct EpiResAtomic {
    static constexpr bool PERM = false;
    float* out; const float* coef; float cmul;
    DEV void operator()(const Acc& acc, const Unit& u, int wr, int wc, int fr, int fq) const {
        const int row0 = wr * 64 + fr, col0 = u.pn * 256 + wc * 32 + 4 * fq;
#pragma unroll
        for (int bj = 0; bj < 2; ++bj)
#pragma unroll
            for (int n = 0; n < 2; ++n) {
                const f32x4 cv = *(const f32x4*)(coef + col0 + bj * 128 + n * 16) * cmul;
#pragma unroll
                for (int ai = 0; ai < 2; ++ai)
#pragma unroll
                    for (int m = 0; m < 4; ++m) { float* p = out + (size_t)(row0 + ai * 128 + m * 16) * D + col0 + bj * 128 + n * 16; const f32x4 v = cv * acc[ai][bj][m][n];
#pragma unroll
                        for (int j = 0; j < 4; ++j) atomicAdd(p + j, v[j]); }
            }
    }
};
struct SplitOrder {
    int G, c;
    HD bool next(int i, Unit& u) const { const int idx = i * G + c; if (idx >= 32) return false; u.pm = 64; u.pn = idx >> 2; u.ko = (idx & 3) * (FF / 4); u.type = 0; return true; }
    DEV void a_ready(const Unit&) const {}
    DEV void done(const Unit&) const {}
};
struct EpiGeluUV {
    static constexpr bool PERM = true;
    bf16* U; bf16* V; const float* rs; const float* sw; float* rsv;
    DEV void operator()(const Acc& acc, const Unit& u, int wr, int wc, int fr, int fq) const {
        const int row0 = u.pm * 256 + wr * 64 + fr, col0 = u.pn * 256 + wc * 32 + 8 * fq;
        const bool isv = u.pn >= 8;
        bf16* O = isv ? V + (col0 - D) : U + col0;
        f32x4 s0[2], s1[2];
#pragma unroll
        for (int bj = 0; bj < 2; ++bj) { s0[bj] = *(const f32x4*)(sw + col0 + bj * 128); s1[bj] = *(const f32x4*)(sw + col0 + bj * 128 + 4); }
        float rv[2][4];
#pragma unroll
        for (int ai = 0; ai < 2; ++ai)
#pragma unroll
            for (int m = 0; m < 4; ++m) rv[ai][m] = rs[row0 + ai * 128 + m * 16];
#pragma unroll
        for (int ai = 0; ai < 2; ++ai)
#pragma unroll
            for (int m = 0; m < 4; ++m) {
                const int row = row0 + ai * 128 + m * 16;
                const float r = rsq_f(rv[ai][m]);
                float ss = 0.f;
#pragma unroll
                for (int bj = 0; bj < 2; ++bj) {
                    f32x4 v0 = acc[ai][bj][m][0] * r + s0[bj], v1 = acc[ai][bj][m][1] * r + s1[bj];
#pragma unroll
                    for (int j = 0; j < 4; j += 2) { const f32x2 a0 = gelu_tanh_pk((f32x2){v0[j], v0[j + 1]}), a1 = gelu_tanh_pk((f32x2){v1[j], v1[j + 1]});
                        v0[j] = a0.x; v0[j + 1] = a0.y; v1[j] = a1.x; v1[j + 1] = a1.y; const f32x2 q = a0 * a0 + a1 * a1; ss += q.x + q.y; }
                    u32x4 w; w.x = cvt_pk_bf16(v0[0], v0[1]); w.y = cvt_pk_bf16(v0[2], v0[3]); w.z = cvt_pk_bf16(v1[0], v1[1]); w.w = cvt_pk_bf16(v1[2], v1[3]);
                    *(u32x4*)(O + (size_t)row * D + bj * 128) = w;
                }
                if (isv) { ss += __shfl_xor(ss, 16); ss += __shfl_xor(ss, 32); if (fq == 0) atomicAdd(rsv + row, ss); }
            }
    }
};
template <bool GELU_SS> struct EpiT {
    static constexpr bool PERM = true;
    bf16* O; int ldc; const float* rs; const float* sw; float* SS;
    DEV void operator()(const Acc& acc, const Unit& u, int wr, int wc, int fr, int fq) const {
        const int row0 = u.pm * 256 + wr * 64 + fr, col0 = u.pn * 256 + wc * 32 + 8 * fq;
        const bool sc = u.pn < 64;
        float shv[2][4];
#pragma unroll
        for (int ai = 0; ai < 2; ++ai)
#pragma unroll
            for (int m = 0; m < 4; ++m) shv[ai][m] = sc ? sw[row0 + ai * 128 + m * 16] : 0.0f;
#pragma unroll
        for (int bj = 0; bj < 2; ++bj) {
            f32x4 r0 = (f32x4){1.f, 1.f, 1.f, 1.f}, r1 = r0;
            if (sc) { const f32x4 a0 = *(const f32x4*)(rs + col0 + bj * 128), a1 = *(const f32x4*)(rs + col0 + bj * 128 + 4);
#pragma unroll
                for (int j = 0; j < 4; ++j) { r0[j] = rsq_f(a0[j]); r1[j] = rsq_f(a1[j]); } }
            float ss[8];
#pragma unroll
            for (int j = 0; j < 8; ++j) ss[j] = 0.f;
#pragma unroll
            for (int ai = 0; ai < 2; ++ai)
#pragma unroll
                for (int m = 0; m < 4; ++m) {
                    const int row = row0 + ai * 128 + m * 16;
                    const float sh = shv[ai][m];
                    f32x4 v0 = acc[ai][bj][m][0] * r0 + sh, v1 = acc[ai][bj][m][1] * r1 + sh;
                    if (GELU_SS) {
#pragma unroll
                        for (int j = 0; j < 4; ++j) { v0[j] = gelu_tanh_f(v0[j]); v1[j] = gelu_tanh_f(v1[j]); ss[j] += v0[j] * v0[j]; ss[4 + j] += v1[j] * v1[j]; } }
                    u32x4 w; w.x = cvt_pk_bf16(v0[0], v0[1]); w.y = cvt_pk_bf16(v0[2], v0[3]); w.z = cvt_pk_bf16(v1[0], v1[1]); w.w = cvt_pk_bf16(v1[2], v1[3]);
                    *(u32x4*)(O + (size_t)row * ldc + col0 + bj * 128) = w;
                }
            if (GELU_SS) {
#pragma unroll
                for (int j = 0; j < 8; ++j) { float t = ss[j]; t += __shfl_xor(t, 1); t += __shfl_xor(t, 2); t += __shfl_xor(t, 4); t += __shfl_xor(t, 8); ss[j] = t; }
                if (fr == 0) { float* dst = SS + (size_t)(u.pm * 2 + wr) * SEQ + col0 + bj * 128; *(f32x4*)dst = (f32x4){ss[0], ss[1], ss[2], ss[3]}; *(f32x4*)(dst + 4) = (f32x4){ss[4], ss[5], ss[6], ss[7]}; }
            }
        }
    }
};
struct EpiQKV {
    static constexpr bool PERM = true;
    bf16* O; const f32x2* rope; const float* rs; const float* sw;
    DEV void operator()(const Acc& acc, const Unit& u, int wr, int wc, int fr, int fq) const {
        const int row0 = u.pm * 256 + wr * 64 + fr, col0 = u.pn * 256 + wc * 32 + 8 * fq;
        const bool lat = (u.pm < 64);
        f32x4 s0[2], s1[2];
#pragma unroll
        for (int bj = 0; bj < 2; ++bj) { s0[bj] = lat ? *(const f32x4*)(sw + col0 + bj * 128) : (f32x4){0.f, 0.f, 0.f, 0.f}; s1[bj] = lat ? *(const f32x4*)(sw + col0 + bj * 128 + 4) : (f32x4){0.f, 0.f, 0.f, 0.f}; }
        float rv[2][4];
#pragma unroll
        for (int ai = 0; ai < 2; ++ai)
#pragma unroll
            for (int m = 0; m < 4; ++m) rv[ai][m] = lat ? rs[row0 + ai * 128 + m * 16] : 0.0f;
#pragma unroll
        for (int ai = 0; ai < 2; ++ai)
#pragma unroll
            for (int m = 0; m < 4; ++m) {
                const int row = row0 + ai * 128 + m * 16;
                bf16* rowp = O + (size_t)row * NQK + col0;
                const float r = lat ? rsq_f(rv[ai][m]) : 1.0f;
                f32x4 cA[2], cB[2];
#pragma unroll
                for (int bj = 0; bj < 2; ++bj) {
                    const int j0 = ((col0 + bj * 128) & 127) >> 1;
                    const int pos = (j0 < 32) ? (row >> 6) : (row & 63); const int f0 = j0 & 31;
                    const f32x4* rp4 = (const f32x4*)(rope + (lat ? pos * 32 + f0 : 0));
                    cA[bj] = rp4[0]; cB[bj] = rp4[1];
                }
#pragma unroll
                for (int bj = 0; bj < 2; ++bj) {
                    f32x4 v0 = acc[ai][bj][m][0] * r + s0[bj], v1 = acc[ai][bj][m][1] * r + s1[bj];
                    if (lat) {
                        const f32x2 c0 = (f32x2){cA[bj][0], cA[bj][1]}, c1 = (f32x2){cA[bj][2], cA[bj][3]}, c2 = (f32x2){cB[bj][0], cB[bj][1]}, c3 = (f32x2){cB[bj][2], cB[bj][3]};
                        f32x4 q0, q1;
                        q0[0] = v0[0] * c0.x - v0[1] * c0.y; q0[1] = v0[1] * c0.x + v0[0] * c0.y;
                        q0[2] = v0[2] * c1.x - v0[3] * c1.y; q0[3] = v0[3] * c1.x + v0[2] * c1.y;
                        q1[0] = v1[0] * c2.x - v1[1] * c2.y; q1[1] = v1[1] * c2.x + v1[0] * c2.y;
                        q1[2] = v1[2] * c3.x - v1[3] * c3.y; q1[3] = v1[3] * c3.x + v1[2] * c3.y;
                        v0 = q0; v1 = q1;
                    }
                    u32x4 w; w.x = cvt_pk_bf16(v0[0], v0[1]); w.y = cvt_pk_bf16(v0[2], v0[3]); w.z = cvt_pk_bf16(v1[0], v1[1]); w.w = cvt_pk_bf16(v1[2], v1[3]);
                    *(u32x4*)(rowp + bj * 128) = w;
                }
            }
    }
};

constexpr int FN = 16384;
HD f32x2 mk2(float a, float b) { f32x2 r; r.x = a; r.y = b; return r; }
HD f32x2 cmulf(f32x2 a, f32x2 b) { const f32x2 t = b * mk2(a.x, a.x); return __builtin_elementwise_fma(mk2(-b.y, b.x), mk2(a.y, a.y), t); }
HD f32x2 cmulcf(f32x2 a, f32x2 b) { const f32x2 t = a * mk2(b.x, b.x); return __builtin_elementwise_fma(mk2(a.y, -a.x), mk2(b.y, b.y), t); }
HD int drev4(int f) {
#if defined(__HIP_DEVICE_COMPILE__)
    unsigned r = __brev((unsigned)f) >> 18;
#else
    unsigned r = 0; for (int i = 0; i < 14; ++i) r |= (((unsigned)f >> i) & 1u) << (13 - i);
#endif
    return (int)(((r & 0x1555u) << 1) | ((r >> 1) & 0x1555u));
}
HD int fpad(int e) { return e + (e >> 4); }
constexpr int FBUF = FN + FN / 16;
template <class TT> HD f32x2 twid(TT T1, TT T2, int m) { return cmulf(T1[m >> 6], T2[m & 63]); }
HD void bfly4(f32x2& a, f32x2& b, f32x2& c, f32x2& d, bool inv) {
    const f32x2 t0 = a + c, t1 = a - c, t2 = b + d, dd = b - d;
    const f32x2 t3 = inv ? mk2(-dd.y, dd.x) : mk2(dd.y, -dd.x);
    a = t0 + t2; b = t1 + t3; c = t0 - t2; d = t1 - t3;
}
template <bool INV, bool HALF = false, class P2, class TT>
HD void fft_pass4(P2 buf, int tid, int nthr, TT T1, TT T2) {
    constexpr int qs = FN / 4;
    const int ou = nthr + (nthr >> 4), oq = qs + (qs >> 4);
    for (int j0 = tid; j0 < qs; j0 += 4 * nthr) {
        const int pb = fpad(j0);
        f32x2 e[4][4];
#pragma unroll
        for (int u = 0; u < 4; ++u)
#pragma unroll
            for (int r = 0; r < ((HALF && !INV) ? 2 : 4); ++r) e[u][r] = buf[pb + u * ou + r * oq];
#pragma unroll
        for (int u = 0; u < 4; ++u) {
            const f32x2 w1 = twid(T1, T2, j0 + u * nthr), w2 = cmulf(w1, w1), w3 = cmulf(w2, w1);
            if (INV) { e[u][1] = cmulcf(e[u][1], w1); e[u][2] = cmulcf(e[u][2], w2); e[u][3] = cmulcf(e[u][3], w3); }
            if (HALF && !INV) {
                const f32x2 xa = e[u][0], xb = e[u][1], t3 = mk2(xb.y, -xb.x);
                e[u][0] = xa + xb; e[u][1] = xa + t3; e[u][2] = xa - xb; e[u][3] = xa - t3;
            } else if (HALF && INV) {
                const f32x2 t0 = e[u][0] + e[u][2], t1 = e[u][0] - e[u][2], t2 = e[u][1] + e[u][3], dd = e[u][1] - e[u][3];
                e[u][0] = t0 + t2; e[u][1] = t1 + mk2(-dd.y, dd.x);
            } else bfly4(e[u][0], e[u][1], e[u][2], e[u][3], INV);
            if (!INV) { e[u][1] = cmulf(e[u][1], w1); e[u][2] = cmulf(e[u][2], w2); e[u][3] = cmulf(e[u][3], w3); }
        }
#pragma unroll
        for (int u = 0; u < 4; ++u)
#pragma unroll
            for (int r = 0; r < ((HALF && INV) ? 2 : 4); ++r) buf[pb + u * ou + r * oq] = e[u][r];
    }
}
template <bool INV, class P2, class TT>
HD void fft_pass16(P2 buf, int s, int tid, int nthr, TT T1, TT T2) {
    const int shs = 14 - 2 * s, lq1 = shs - 4, q1 = 1 << lq1, qs = q1 << 2;
    constexpr float CR[10] = {1.0f, 0.9238795325112867f, 0.7071067811865476f, 0.3826834323650898f, 0.0f, -0.3826834323650898f, -0.7071067811865476f, -0.9238795325112867f, -1.0f, -0.9238795325112867f};
    constexpr float CI[10] = {0.0f, -0.3826834323650898f, -0.7071067811865476f, -0.9238795325112867f, -1.0f, -0.9238795325112867f, -0.7071067811865476f, -0.3826834323650898f, 0.0f, 0.3826834323650898f};
    const int o1 = (lq1 >= 4) ? q1 + (q1 >> 4) : q1, os = (lq1 >= 4) ? qs + (qs >> 4) : qs;
    for (int b0 = tid; b0 < FN / 16; b0 += 2 * nthr) {
        f32x2 x[2][4][4]; int base[2], jpv[2];
#pragma unroll
        for (int it = 0; it < 2; ++it) {
            const int b = b0 + it * nthr, grp = b >> lq1; jpv[it] = b & (q1 - 1); base[it] = fpad((grp << shs) + jpv[it]);
#pragma unroll
            for (int r1 = 0; r1 < 4; ++r1)
#pragma unroll
                for (int r2 = 0; r2 < 4; ++r2) x[it][r1][r2] = buf[base[it] + r1 * os + r2 * o1];
        }
#pragma unroll
        for (int it = 0; it < 2; ++it) {
            const f32x2 Wb = twid(T1, T2, jpv[it] << (2 * s));
            const f32x2 Wb2 = cmulf(Wb, Wb), Wb3 = cmulf(Wb2, Wb), Wb4 = cmulf(Wb2, Wb2), Wb8 = cmulf(Wb4, Wb4), Wb12 = cmulf(Wb8, Wb4);
            if (!INV) {
#pragma unroll
                for (int r2 = 0; r2 < 4; ++r2) {
                    bfly4(x[it][0][r2], x[it][1][r2], x[it][2][r2], x[it][3][r2], false);
                    x[it][1][r2] = cmulf(x[it][1][r2], cmulf(Wb, mk2(CR[r2], CI[r2])));
                    x[it][2][r2] = cmulf(x[it][2][r2], cmulf(Wb2, mk2(CR[2 * r2], CI[2 * r2])));
                    x[it][3][r2] = cmulf(x[it][3][r2], cmulf(Wb3, mk2(CR[3 * r2], CI[3 * r2])));
                }
#pragma unroll
                for (int r1 = 0; r1 < 4; ++r1) {
                    bfly4(x[it][r1][0], x[it][r1][1], x[it][r1][2], x[it][r1][3], false);
                    x[it][r1][1] = cmulf(x[it][r1][1], Wb4); x[it][r1][2] = cmulf(x[it][r1][2], Wb8); x[it][r1][3] = cmulf(x[it][r1][3], Wb12);
                }
            } else {
#pragma unroll
                for (int r1 = 0; r1 < 4; ++r1) {
                    x[it][r1][1] = cmulcf(x[it][r1][1], Wb4); x[it][r1][2] = cmulcf(x[it][r1][2], Wb8); x[it][r1][3] = cmulcf(x[it][r1][3], Wb12);
                    bfly4(x[it][r1][0], x[it][r1][1], x[it][r1][2], x[it][r1][3], true);
                }
#pragma unroll
                for (int r2 = 0; r2 < 4; ++r2) {
                    x[it][1][r2] = cmulcf(x[it][1][r2], cmulf(Wb, mk2(CR[r2], CI[r2])));
                    x[it][2][r2] = cmulcf(x[it][2][r2], cmulf(Wb2, mk2(CR[2 * r2], CI[2 * r2])));
                    x[it][3][r2] = cmulcf(x[it][3][r2], cmulf(Wb3, mk2(CR[3 * r2], CI[3 * r2])));
                    bfly4(x[it][0][r2], x[it][1][r2], x[it][2][r2], x[it][3][r2], true);
                }
            }
        }
#pragma unroll
        for (int it = 0; it < 2; ++it)
#pragma unroll
            for (int r1 = 0; r1 < 4; ++r1)
#pragma unroll
                for (int r2 = 0; r2 < 4; ++r2) buf[base[it] + r1 * os + r2 * o1] = x[it][r1][r2];
    }
}
HD void ks_store(f32x4* p, f32x4 v) { *p = v; }
HD f32x4 ks_load(const f32x4* p) { return *p; }
HD unsigned ks_pk(float lo, float hi) {
#if defined(__HIP_DEVICE_COMPILE__)
    return cvt_pk_bf16(lo, hi);
#else
    unsigned a, b; __builtin_memcpy(&a, &lo, 4); __builtin_memcpy(&b, &hi, 4); a += 0x7fffu + ((a >> 16) & 1u); b += 0x7fffu + ((b >> 16) & 1u); return (a >> 16) | (b & 0xffff0000u);
#endif
}
HD float ks_up(unsigned h) { const unsigned u = h << 16; float f; __builtin_memcpy(&f, &u, 4); return f; }
HD void ks_store(u32x2* p, f32x4 v) { u32x2 w; w.x = ks_pk(v[0], v[1]); w.y = ks_pk(v[2], v[3]); *p = w; }
HD f32x4 ks_load(const u32x2* p) { const u32x2 w = *p; f32x4 r; r[0] = ks_up(w.x & 0xffffu); r[1] = ks_up(w.x >> 16); r[2] = ks_up(w.y & 0xffffu); r[3] = ks_up(w.y >> 16); return r; }
template <class P2, class K4>
HD void fft_make_ks(P2 buf, K4 ks, float scale, int tid, int nthr) {
    for (int f = tid; f <= FN / 2; f += nthr) {
        const int p = drev4(f), pp = drev4((FN - f) & (FN - 1));
        const f32x2 Ak = buf[fpad(p)], Bk = buf[fpad(pp)];
        const float h = 0.5f * scale;
        f32x4 o; o[0] = h * (Ak.x + Bk.x); o[1] = h * (Ak.y - Bk.y); o[2] = h * (Ak.y + Bk.y); o[3] = -h * (Ak.x - Bk.x);
        ks_store(ks + f, o);
    }
}
template <class P2, class TT, class K4>
HD void fft_pointwise(P2 buf, K4 ks, int tid, int nthr, TT T1, TT T2) {
#if defined(__HIP_DEVICE_COMPILE__)
#pragma unroll 4
#endif
    for (int f = tid; f <= FN / 2; f += nthr) {
        const int p = drev4(f), pp = drev4((FN - f) & (FN - 1));
        const f32x4 kv = ks_load(ks + f);
        const f32x2 A = buf[fpad(p)], Bq = buf[fpad(pp)];
        const f32x2 Ve = mk2(0.5f * (A.x + Bq.x), 0.5f * (A.y - Bq.y)), Vo = mk2(0.5f * (A.y + Bq.y), -0.5f * (A.x - Bq.x));
        const f32x2 Ke = mk2(kv[0], kv[1]), Ko = mk2(kv[2], kv[3]);
        const f32x2 oo = cmulf(twid(T1, T2, f), cmulf(Vo, Ko)), ee = cmulf(Ve, Ke);
        const f32x2 Ye = mk2(ee.x + oo.x, ee.y + oo.y);
        const f32x2 eo = cmulf(Ve, Ko), oe = cmulf(Vo, Ke);
        const f32x2 Yo = mk2(eo.x + oe.x, eo.y + oe.y);
        buf[fpad(p)] = mk2(Ye.x - Yo.y, Ye.y + Yo.x);
        if (pp != p) buf[fpad(pp)] = mk2(Ye.x + Yo.y, -Ye.y + Yo.x);
    }
}
#define FFT_FWD(buf, tid, nthr, T1, T2, SYNC) do { fft_pass4<false>(buf, tid, nthr, T1, T2); SYNC; fft_pass16<false>(buf, 1, tid, nthr, T1, T2); SYNC; fft_pass16<false>(buf, 3, tid, nthr, T1, T2); SYNC; fft_pass16<false>(buf, 5, tid, nthr, T1, T2); SYNC; } while (0)
#define FFT_FWD_H(buf, tid, nthr, T1, T2, SYNC) do { fft_pass4<false, true>(buf, tid, nthr, T1, T2); SYNC; fft_pass16<false>(buf, 1, tid, nthr, T1, T2); SYNC; fft_pass16<false>(buf, 3, tid, nthr, T1, T2); SYNC; fft_pass16<false>(buf, 5, tid, nthr, T1, T2); SYNC; } while (0)
#define FFT_INV_H(buf, tid, nthr, T1, T2, SYNC) do { fft_pass16<true>(buf, 5, tid, nthr, T1, T2); SYNC; fft_pass16<true>(buf, 3, tid, nthr, T1, T2); SYNC; fft_pass16<true>(buf, 1, tid, nthr, T1, T2); SYNC; fft_pass4<true, true>(buf, tid, nthr, T1, T2); SYNC; } while (0)
#define FFT_INV(buf, tid, nthr, T1, T2, SYNC) do { fft_pass16<true>(buf, 5, tid, nthr, T1, T2); SYNC; fft_pass16<true>(buf, 3, tid, nthr, T1, T2); SYNC; fft_pass16<true>(buf, 1, tid, nthr, T1, T2); SYNC; fft_pass4<true>(buf, tid, nthr, T1, T2); SYNC; } while (0)

#if !defined(HOST_TEST)
struct CvtJob { const float* src; bf16* dst; const float* shift; float* sw; const float* fg; const float* fs; bf16* dst2; int K, N, kind, tile0; };
constexpr int NJOBS = 16;
struct Args {
    const float* in[29]; float* out; unsigned char* ws; CvtJob jobs[NJOBS]; int ph_lo, ph_hi, ncvt, ncvt_early, ncvt_p1, pad1;
};
enum { I_X = 0, I_C, I_CTX, I_CCTX, I_ADAW, I_ADAB, I_NORMG, I_WG, I_WU, I_WD, I_EVWIN, I_CONVW, I_CONVB, I_HW1, I_HB1, I_HF1, I_HW2, I_HB2, I_HF2, I_HW3, I_SKIP, I_SINK, I_EVWOUT,
       I_ODWIN, I_SGG, I_SGWS, I_SGBS, I_ODWOUT, I_FING };

constexpr int N_ADA = 288, N_TAB = 1, N_FILT = 128;
DEV int cvt_map(int kind, int n) {
    if (kind == 1) return (n >> 7) * 256 + (n & 127);
    if (kind == 2) return (n >> 7) * 256 + 128 + (n & 127);
    if (kind == 3) {
        if (n < HYIN) return n;
        if (n >= HYIN + 1280) return HYIN + (n - (HYIN + 1280));
        const int d = n & 127; return 256 + (n & ~127) + (d < 64 ? 2 * d : 2 * (d - 64) + 1);
    }
    return n;
}
DEV void cvt_issue(const CvtJob& J, int tile, int tid, f32x4 (&v)[8]) {
    const int ntn = J.N >> 7, kt = tile / ntn, nt = tile - kt * ntn;
    const int wv_ = tid >> 6, ln_ = tid & 63, ko = 8 * (wv_ & 1) + (ln_ >> 3), nq = 8 * (wv_ >> 1) + (ln_ & 7);
    const float* src = J.src + (size_t)(kt * 128 + ko * 8) * J.N + nt * 128 + nq * 4;
#pragma unroll
    for (int i = 0; i < 8; ++i) v[i] = __builtin_nontemporal_load((const f32x4*)(src + (size_t)i * J.N));
}
DEV void cvt_finish(const CvtJob& J, int tile, int tid, const f32x4 (&v)[8]) {
    const int ntn = J.N >> 7, kt = tile / ntn, nt = tile - kt * ntn;
    const int wv_ = tid >> 6, ln_ = tid & 63, ko = 8 * (wv_ & 1) + (ln_ >> 3), nq = 8 * (wv_ >> 1) + (ln_ & 7);
    float f[8];
    if (J.shift) {
        const f32x4 g0 = *(const f32x4*)(J.fg + kt * 128 + ko * 8), g1 = *(const f32x4*)(J.fg + kt * 128 + ko * 8 + 4), c0 = *(const f32x4*)(J.fs + kt * 128 + ko * 8), c1 = *(const f32x4*)(J.fs + kt * 128 + ko * 8 + 4);
#pragma unroll
        for (int i = 0; i < 4; ++i) { f[i] = g0[i] * (1.0f + c0[i]); f[4 + i] = g1[i] * (1.0f + c1[i]); }
    } else {
#pragma unroll
        for (int i = 0; i < 8; ++i) f[i] = 1.0f;
    }
#pragma unroll
    for (int j = 0; j < 4; ++j) {
        u32x4 w; w.x = cvt_pk_bf16(v[0][j] * f[0], v[1][j] * f[1]); w.y = cvt_pk_bf16(v[2][j] * f[2], v[3][j] * f[3]); w.z = cvt_pk_bf16(v[4][j] * f[4], v[5][j] * f[5]); w.w = cvt_pk_bf16(v[6][j] * f[6], v[7][j] * f[7]);
        const int n = nt * 128 + nq * 4 + j, drow = cvt_map(J.kind, n);
        *(u32x4*)(J.dst + (size_t)drow * J.K + kt * 128 + ko * 8) = w;
        if (J.dst2 && n >= HYIN + 1024) {
            u32x4 wu; wu.x = cvt_pk_bf16(v[0][j], v[1][j]); wu.y = cvt_pk_bf16(v[2][j], v[3][j]); wu.z = cvt_pk_bf16(v[4][j], v[5][j]); wu.w = cvt_pk_bf16(v[6][j], v[7][j]);
            const int r2 = (n >= HYIN + 1280) ? (n - (HYIN + 1280)) : 256 + (drow - (NZT + 1024));
            *(u32x4*)(J.dst2 + (size_t)r2 * J.K + kt * 128 + ko * 8) = wu;
        }
    }
    if (J.shift) {
        const f32x4 s0 = *(const f32x4*)(J.shift + kt * 128 + ko * 8), s1 = *(const f32x4*)(J.shift + kt * 128 + ko * 8 + 4);
        f32x4 p = v[0] * s0[0] + v[1] * s0[1] + v[2] * s0[2] + v[3] * s0[3] + v[4] * s1[0] + v[5] * s1[1] + v[6] * s1[2] + v[7] * s1[3];
#pragma unroll
        for (int j = 0; j < 4; ++j) { float t = p[j]; t += __shfl_xor(t, 8); t += __shfl_xor(t, 16); t += __shfl_xor(t, 32); p[j] = t; }
        if (ln_ < 8) {
#pragma unroll
            for (int j = 0; j < 4; ++j) atomicAdd(J.sw + cvt_map(J.kind, nt * 128 + nq * 4 + j), p[j]);
        }
    }
}
DEV int cvt_job_of(const Args& a, int t) {
    int j = 0;
#pragma unroll 1
    for (int q = 1; q < NJOBS; ++q) if (t >= a.jobs[q].tile0) j = q;
    return j;
}
DEV void cvt_tile(const Args& a, int t, int tid) { const int j = cvt_job_of(a, t); f32x4 v[8]; cvt_issue(a.jobs[j], t - a.jobs[j].tile0, tid, v); cvt_finish(a.jobs[j], t - a.jobs[j].tile0, tid, v); }
DEV void ada_unit(const Args& a, unsigned char* ws, int u, LAS unsigned char* lds, int tid) {
    LAS float* sv = (LAS float*)lds;
    LAS float* red = (LAS float*)(lds + 16384);
    const int l = u / 144, cg = u - l * 144, n0 = cg * 128, w = tid >> 6, lane = tid & 63, rsub = lane >> 5, c4 = lane & 31;
    for (int k = tid; k < D; k += NTHR) { const float c = a.in[I_C][k], cc = a.in[I_CCTX][k]; sv[k] = c / (1.0f + expf(-c)); sv[D + k] = cc / (1.0f + expf(-cc)); }
    __syncthreads();
    const float* W = a.in[I_ADAW] + (size_t)l * D * (NMOD * D) + n0 + 4 * c4;
    f32x4 al = (f32x4){0.f, 0.f, 0.f, 0.f}, ac = al;
    const int k0 = w * 256 + rsub;
#pragma unroll 1
    for (int kk = 0; kk < 256; kk += 32) {
        f32x4 wv[16];
#pragma unroll
        for (int i = 0; i < 16; ++i) wv[i] = __builtin_nontemporal_load((const f32x4*)(W + (size_t)(k0 + kk + 2 * i) * (NMOD * D)));
#pragma unroll
        for (int i = 0; i < 16; ++i) { const float sl = sv[k0 + kk + 2 * i], sc = sv[D + k0 + kk + 2 * i]; al += wv[i] * sl; ac += wv[i] * sc; }
    }
#pragma unroll
    for (int j = 0; j < 4; ++j) { al[j] += __shfl_xor(al[j], 32); ac[j] += __shfl_xor(ac[j], 32); }
    if (rsub == 0) { *(LAS f32x4*)(red + (w * 2 + 0) * 128 + 4 * c4) = al; *(LAS f32x4*)(red + (w * 2 + 1) * 128 + 4 * c4) = ac; }
    __syncthreads();
    if (tid < 256) {
        const int sI = tid >> 7, col = tid & 127;
        float t = 0.f;
#pragma unroll
        for (int ww = 0; ww < 8; ++ww) t += red[(ww * 2 + sI) * 128 + col];
        float* mod = (float*)(ws + WS_MOD);
        mod[(size_t)(l * 2 + sI) * (NMOD * D) + n0 + col] = t + a.in[I_ADAB][(size_t)l * (NMOD * D) + n0 + col];
    }
    __syncthreads();
}
DEV void table_unit(const Args& a, unsigned char* ws, int which, int tid) {
    f32x2* tab = (f32x2*)(ws + WS_ROPE);
    for (int i = tid; i < 256 * 32; i += NTHR) { const int pos = i >> 5, f = i & 31; const float inv = powf(10000.0f, -(float)f / 32.0f); const float ang = (float)pos * inv; tab[i] = (f32x2){cosf(ang), sinf(ang)}; }
}
typedef float f32x16 __attribute__((ext_vector_type(16)));
DEV void split_bf16x8(const float (&x)[8], bf16x8& hi, bf16x8& lo) {
    u32x4 h, l;
#pragma unroll
    for (int i = 0; i < 4; ++i) { const unsigned hw = cvt_pk_bf16(x[2 * i], x[2 * i + 1]); h[i] = hw; l[i] = cvt_pk_bf16(x[2 * i] - bflo(hw), x[2 * i + 1] - bfhi(hw)); }
    __builtin_memcpy(&hi, &h, 16); __builtin_memcpy(&lo, &l, 16);
}
DEV void filter_unit(const Args& a, unsigned char* ws, int fu, LAS unsigned char* lds, int tid) {
    constexpr int HP = 72;
    const int n0 = fu * 128, w = __builtin_amdgcn_readfirstlane(tid >> 6), lane = tid & 63, c = lane & 31, hi = lane >> 5;
    LAS unsigned short* H2hi = (LAS unsigned short*)lds; LAS unsigned short* H2lo = H2hi + 128 * HP;
    LAS float* zrow = (LAS float*)(lds + 2 * 128 * HP * 2) + w * 40; LAS float* h1row = (LAS float*)(lds + 2 * 128 * HP * 2 + 8 * 160) + w * 64;
    {
        LAS float* wst = (LAS float*)(lds + 2 * 128 * HP * 2 + 8 * 160 + 8 * 256);
        for (int i = tid; i < 33 * 64; i += NTHR) wst[i] = a.in[I_HW1][i];
        for (int i = tid; i < 64 * 64; i += NTHR) wst[33 * 64 + i] = a.in[I_HW2][i];
        __syncthreads();
        float w1c[33], w2c[64];
#pragma unroll
        for (int i = 0; i < 33; ++i) w1c[i] = wst[i * 64 + lane];
#pragma unroll
        for (int i = 0; i < 64; ++i) w2c[i] = wst[33 * 64 + i * 64 + lane];
        const float b1 = a.in[I_HB1][lane], f1 = a.in[I_HF1][lane], b2 = a.in[I_HB2][lane], f2 = a.in[I_HF2][lane];
#pragma unroll 1
        for (int i = 0; i < 16; ++i) {
            const int nl = w * 16 + i, n = n0 + nl;
            if (lane < 33) {
                float z;
                if (lane == 0) z = (float)n / (float)(SEQ - 1);
                else { const int b = (lane - 1) & 15; const float band = 1e-4f + (float)b * ((15.0f - 1e-4f) / 15.0f); const float wv = (6.283185307179586f / (float)SEQ) * (float)n; const float ang = band * wv; z = (lane <= 16) ? cosf(ang) : -sinf(ang); }
                zrow[lane] = z;
            }
            __builtin_amdgcn_wave_barrier();
            float s1 = b1;
#pragma unroll
            for (int k = 0; k < 33; ++k) s1 += zrow[k] * w1c[k];
            h1row[lane] = sinf(f1 * s1);
            __builtin_amdgcn_wave_barrier();
            float s2 = b2;
#pragma unroll
            for (int k = 0; k < 64; k += 4) { const f32x4 hv = *(const LAS f32x4*)(h1row + k); s2 += hv[0] * w2c[k] + hv[1] * w2c[k + 1] + hv[2] * w2c[k + 2] + hv[3] * w2c[k + 3]; }
            const float h2 = sinf(f2 * s2);
            const unsigned hw = cvt_pk_bf16(h2, 0.f); const unsigned lw = cvt_pk_bf16(h2 - bflo(hw), 0.f);
            H2hi[nl * HP + lane] = (unsigned short)(hw & 0xffffu); H2lo[nl * HP + lane] = (unsigned short)(lw & 0xffffu);
            __builtin_amdgcn_wave_barrier();
        }
    }
    __syncthreads();
    const float lt = -4.605170185988091f, d0 = lt / 1.5f, d1 = lt / 0.3f;
    bf16* kt = (bf16*)(ws + WS_KT);
    const float* w3 = a.in[I_HW3];
#pragma unroll 1
    for (int rb = 0; rb < 8; ++rb) {
        const int cp0 = w * 256 + rb * 32;
        bf16x8 Ah[4], Al[4];
#pragma unroll
        for (int ks = 0; ks < 4; ++ks) {
            float x[8];
#pragma unroll
            for (int i = 0; i < 8; ++i) x[i] = w3[(size_t)(ks * 16 + 8 * hi + i) * (2 * HYW) + cp0 + c];
            split_bf16x8(x, Ah[ks], Al[ks]);
        }
#pragma unroll 1
        for (int nb = 0; nb < 4; ++nb) {
            f32x16 acc;
#pragma unroll
            for (int r = 0; r < 16; ++r) acc[r] = 0.f;
#pragma unroll
            for (int ks = 0; ks < 4; ++ks) {
                const bf16x8 bh = *(const LAS bf16x8*)((const LAS unsigned char*)H2hi + ((nb * 32 + c) * HP + ks * 16 + 8 * hi) * 2);
                const bf16x8 bl = *(const LAS bf16x8*)((const LAS unsigned char*)H2lo + ((nb * 32 + c) * HP + ks * 16 + 8 * hi) * 2);
                acc = __builtin_amdgcn_mfma_f32_32x32x16_bf16(Ah[ks], bh, acc, 0, 0, 0);
                acc = __builtin_amdgcn_mfma_f32_32x32x16_bf16(Ah[ks], bl, acc, 0, 0, 0);
                acc = __builtin_amdgcn_mfma_f32_32x32x16_bf16(Al[ks], bh, acc, 0, 0, 0);
            }
            const int n = n0 + nb * 32 + c;
            const float tn = (float)n / (float)(SEQ - 1) * 1.4426950408889634f;
#pragma unroll
            for (int r = 0; r < 16; ++r) {
                const int cp = cp0 + (r & 3) + 8 * (r >> 2) + 4 * hi, dir = cp >> 10, ch = cp & 1023;
                const float delta = fabsf(d0 + (d1 - d0) * ((float)ch / (float)(HYW - 1)));
                kt[((size_t)ch * 2 + dir) * SEQ + n] = (bf16)(cvt_pk_bf16(acc[r] * __builtin_amdgcn_exp2f(-tn * delta), 0.f) & 0xffffu);
            }
        }
    }
    __syncthreads();
}
DEV int cvt_start(int b) { const int f = b - 33; return 24 * b - 5 * (b < 32 ? b : 32) - 8 * (f < 0 ? 0 : (f > 128 ? 128 : f)); }
DEV void phase_prologue(const Args& a, unsigned char* ws, LAS unsigned char* lds, int bid, int nb, int tid) {
    const int total = N_ADA + N_TAB + N_FILT;
    for (int it = bid; it < total; it += nb) {
        if (it < N_ADA) ada_unit(a, ws, it, lds, tid);
        else if (it < N_ADA + N_TAB) table_unit(a, ws, it - N_ADA, tid);
        else filter_unit(a, ws, it - N_ADA - N_TAB, lds, tid);
    }
    if (nb == 256) { int t0 = cvt_start(bid), t1 = cvt_start(bid + 1); if (t1 > a.ncvt_early || bid == 255) t1 = a.ncvt_early; for (int t = t0; t < t1; ++t) cvt_tile(a, t, tid); }
    else for (int t = bid; t < a.ncvt_early; t += nb) cvt_tile(a, t, tid);
}
DEV void phase_norm(const float* xlat, const float* xc, int nrows, const float* g, const float* mod_lat, const float* mod_ctx, int kshift, bf16* XN, float* xc_copy, LAS unsigned char* lds, int bid, int nb, int tid) {
    LAS float* gs = (LAS float*)lds;
    LAS float* sh = gs + 2 * D;
    for (int k = tid; k < D; k += NTHR) {
        const float gg = g[k];
        gs[k] = gg * (1.0f + mod_lat[(kshift + 1) * D + k]); sh[k] = mod_lat[kshift * D + k];
        gs[D + k] = gg * (1.0f + mod_ctx[(kshift + 1) * D + k]); sh[D + k] = mod_ctx[kshift * D + k];
    }
    __syncthreads();
    const int w = tid >> 6, lane = tid & 63;
    for (int r0 = (bid * 8 + w) * 2; r0 < nrows; r0 += nb * 16) {
        f32x4 v[2][8]; float ss[2];
#pragma unroll
        for (int h = 0; h < 2; ++h) {
            const int r = r0 + h; const bool cx = r >= SEQ;
            const float* src = cx ? xc + (size_t)(r - SEQ) * D : xlat + (size_t)r * D;
#pragma unroll
            for (int i = 0; i < 8; ++i) v[h][i] = (r < nrows) ? *(const f32x4*)(src + (i * 64 + lane) * 4) : (f32x4){0.f, 0.f, 0.f, 0.f};
        }
#pragma unroll
        for (int h = 0; h < 2; ++h) {
            const int r = r0 + h; const bool cx = r >= SEQ;
            if (r >= nrows) break;
            float s2 = 0.f;
#pragma unroll
            for (int i = 0; i < 8; ++i) s2 += v[h][i][0] * v[h][i][0] + v[h][i][1] * v[h][i][1] + v[h][i][2] * v[h][i][2] + v[h][i][3] * v[h][i][3];
            if (cx && xc_copy) {
#pragma unroll
                for (int i = 0; i < 8; ++i) *(f32x4*)(xc_copy + (size_t)(r - SEQ) * D + (i * 64 + lane) * 4) = v[h][i]; }
            ss[h] = wave_sum(s2);
            const float rstd = 1.0f / sqrtf(ss[h] * (1.0f / D) + EPS);
            const LAS float* gp = gs + (cx ? D : 0); const LAS float* sp = sh + (cx ? D : 0);
#pragma unroll
            for (int i = 0; i < 8; ++i) {
                const int col = (i * 64 + lane) * 4;
                const f32x4 gv = *(const LAS f32x4*)(gp + col), sv = *(const LAS f32x4*)(sp + col);
                const f32x4 y = v[h][i] * rstd * gv + sv;
                u32x2 o; o.x = cvt_pk_bf16(y[0], y[1]); o.y = cvt_pk_bf16(y[2], y[3]);
                *(u32x2*)(XN + (size_t)r * D + col) = o;
            }
        }
    }
}
DEV void ctx_norm_block(const float* XC, const float* g, const float* mod_ctx, int kshift, bf16* XNctx, int tid, LAS unsigned char* lds) {
    LAS float* gsv = (LAS float*)lds; LAS float* shv = gsv + D;
    for (int k = tid; k < D; k += NTHR) { gsv[k] = g[k] * (1.0f + mod_ctx[(kshift + 1) * D + k]); shv[k] = mod_ctx[kshift * D + k]; }
    __syncthreads();
    const int w = tid >> 6, lane = tid & 63;
    for (int r0 = w * 4; r0 < NCTX; r0 += 32) {
        f32x4 v[4][8];
#pragma unroll
        for (int h = 0; h < 4; ++h)
#pragma unroll
            for (int i = 0; i < 8; ++i) v[h][i] = *(const f32x4*)(XC + (size_t)(r0 + h) * D + (i * 64 + lane) * 4);
#pragma unroll
        for (int h = 0; h < 4; ++h) {
            const int r = r0 + h; float ss = 0.f;
#pragma unroll
            for (int i = 0; i < 8; ++i) ss += v[h][i][0] * v[h][i][0] + v[h][i][1] * v[h][i][1] + v[h][i][2] * v[h][i][2] + v[h][i][3] * v[h][i][3];
            ss = wave_sum(ss);
            const float rstd = 1.0f / sqrtf(ss * (1.0f / D) + EPS);
#pragma unroll
            for (int i = 0; i < 8; ++i) {
                const int col = (i * 64 + lane) * 4;
                const f32x4 gv = *(const LAS f32x4*)(gsv + col), sh = *(const LAS f32x4*)(shv + col);
                const f32x4 y = v[h][i] * rstd * gv + sh;
                u32x2 o; o.x = cvt_pk_bf16(y[0], y[1]); o.y = cvt_pk_bf16(y[2], y[3]);
                *(u32x2*)(XNctx + (size_t)r * D + col) = o;
            }
        }
    }
    asm volatile("s_waitcnt vmcnt(0)" ::: "memory");
    __syncthreads();
}
DEV void phase_final_norm(const bf16* xb, float* out, const float* g, int bid, int nb, int tid) {
    const int w = tid >> 6, lane = tid & 63;
    for (int r0 = (bid * 8 + w) * 2; r0 < SEQ; r0 += nb * 16) {
        u32x4 q[2][4];
#pragma unroll
        for (int h = 0; h < 2; ++h)
#pragma unroll
            for (int i = 0; i < 4; ++i) q[h][i] = *(const u32x4*)(xb + (size_t)(r0 + h) * D + (i * 64 + lane) * 8);
#pragma unroll
        for (int h = 0; h < 2; ++h) {
            float v[4][8]; float ss = 0.f;
#pragma unroll
            for (int i = 0; i < 4; ++i) { v[i][0] = bflo(q[h][i].x); v[i][1] = bfhi(q[h][i].x); v[i][2] = bflo(q[h][i].y); v[i][3] = bfhi(q[h][i].y); v[i][4] = bflo(q[h][i].z); v[i][5] = bfhi(q[h][i].z); v[i][6] = bflo(q[h][i].w); v[i][7] = bfhi(q[h][i].w);
#pragma unroll
                for (int j = 0; j < 8; ++j) ss += v[i][j] * v[i][j]; }
            ss = wave_sum(ss);
            const float rstd = 1.0f / sqrtf(ss * (1.0f / D) + EPS);
#pragma unroll
            for (int i = 0; i < 4; ++i) {
                const int col = (i * 64 + lane) * 8; const f32x4 g0 = *(const f32x4*)(g + col), g1 = *(const f32x4*)(g + col + 4);
                *(f32x4*)(out + (size_t)(r0 + h) * D + col) = (f32x4){v[i][0] * rstd * g0[0], v[i][1] * rstd * g0[1], v[i][2] * rstd * g0[2], v[i][3] * rstd * g0[3]};
                *(f32x4*)(out + (size_t)(r0 + h) * D + col + 4) = (f32x4){v[i][4] * rstd * g1[0], v[i][5] * rstd * g1[1], v[i][6] * rstd * g1[2], v[i][7] * rstd * g1[3]};
            }
        }
    }
}

typedef __attribute__((address_space(1))) unsigned char* gptr_t;
DEV unsigned char* fresh_ptr(unsigned char* p) { gptr_t g = (gptr_t)p; asm volatile("" : "+s"(g)); return (unsigned char*)g; }
constexpr int HY_RED = FBUF * 8, HY_T1 = HY_RED + 64, HY_T2 = HY_T1 + 1040;
DEV void hyena_tables(LAS unsigned char* lds, int tid) {
    LAS f32x2* T1 = (LAS f32x2*)(lds + HY_T1); LAS f32x2* T2 = (LAS f32x2*)(lds + HY_T2);
    if (tid < 129) { float sn, cs; sincospif(2.0f * (float)(64 * tid) / (float)FN, &sn, &cs); T1[tid] = mk2(cs, -sn); }
    else if (tid >= 192 && tid < 256) { const int k = tid - 192; float sn, cs; sincospif(2.0f * (float)k / (float)FN, &sn, &cs); T2[k] = mk2(cs, -sn); }
    __syncthreads();
}
DEV f32x2 conv3_pair(unsigned wp, unsigned wc, unsigned wn, int t, float w0, float w1, float w2, float b) {
    const float zm = (t > 0) ? bfhi(wp) : 0.f, z0 = bflo(wc), z1 = bfhi(wc), z2 = (t + 2 < SEQ) ? bflo(wn) : 0.f;
    return mk2(w0 * zm + w1 * z0 + w2 * z1 + b, w0 * z0 + w1 * z1 + w2 * z2 + b);
}
DEV void phase_filter_fft(const Args& a, unsigned char* ws, LAS unsigned char* lds, int bid, int nb, int tid_in) {
    hyena_tables(lds, tid_in);
    LAS f32x2* buf = (LAS f32x2*)lds; LAS float* red = (LAS float*)(lds + HY_RED);
    const LAS f32x2* T1 = (const LAS f32x2*)(lds + HY_T1); const LAS f32x2* T2 = (const LAS f32x2*)(lds + HY_T2);
    f32x4 cv[8]; int ct = a.ncvt_early + bid, cj = 0, cpend = 0;
#define CVT_HOOK do { if (cpend) { cvt_finish(a.jobs[cj], ct - a.jobs[cj].tile0, tid_in, cv); ct += nb; cpend = 0; } \
        if (ct < a.ncvt_p1) { cj = cvt_job_of(a, ct); cvt_issue(a.jobs[cj], ct - a.jobs[cj].tile0, tid_in, cv); cpend = 1; } } while (0)
#define HY_SYNC_HOOK do { __syncthreads(); CVT_HOOK; } while (0)
    for (int c = bid; c < HYW; c += nb) {
        int tid = tid_in; asm volatile("" : "+v"(tid));
        const bf16* hf = (const bf16*)(ws + WS_KT) + (size_t)c * 2 * SEQ; const bf16* hb = hf + SEQ;
        float ssq = 0.f;
        {
            f32x2 v[16];
#pragma unroll
            for (int k = 0; k < 16; ++k) { const unsigned wq = *(const unsigned*)(hf + 2 * (tid + NTHR * k)); v[k] = mk2(bflo(wq), bfhi(wq)); }
#pragma unroll
            for (int k = 0; k < 16; ++k) { ssq += v[k].x * v[k].x + v[k].y * v[k].y; buf[fpad(tid + NTHR * k)] = v[k]; }
            asm volatile("" ::: "memory");
#pragma unroll
            for (int k = 0; k < 16; ++k) { const int n = FN / 2 + tid + NTHR * k; v[k].x = (2 * n == SEQ) ? 0.f : bf2f(hb[2 * SEQ - 2 * n]); v[k].y = bf2f(hb[2 * SEQ - 2 * n - 1]); }
#pragma unroll
            for (int k = 0; k < 16; ++k) { ssq += v[k].x * v[k].x + v[k].y * v[k].y; buf[fpad(FN / 2 + tid + NTHR * k)] = v[k]; }
        }
        ssq = wave_sum(ssq);
        if ((tid & 63) == 0) red[tid >> 6] = ssq;
        HY_SYNC_HOOK;
        float tot = 0.f;
#pragma unroll
        for (int i = 0; i < 8; ++i) tot += red[i];
        const float rho = 1.0f / sqrtf(tot + EPS);
        FFT_FWD(buf, tid, NTHR, T1, T2, HY_SYNC_HOOK);
        fft_make_ks(buf, (u32x2*)(ws + WS_KS) + (size_t)c * KSP, rho * (1.0f / (float)FN), tid, NTHR);
        HY_SYNC_HOOK;
    }
    if (cpend) { cvt_finish(a.jobs[cj], ct - a.jobs[cj].tile0, tid_in, cv); ct += nb; }
    for (; ct < a.ncvt_p1; ct += nb) cvt_tile(a, ct, tid_in);
#undef CVT_HOOK
#undef HY_SYNC_HOOK
}
DEV void hyena_channel(const Args& a, unsigned char* ws, int c, LAS unsigned char* lds, int bid, int tid_in) {
    int tid = tid_in; asm volatile("" : "+v"(tid));
    LAS f32x2* buf = (LAS f32x2*)lds;
    const LAS f32x2* T1 = (const LAS f32x2*)(lds + HY_T1); const LAS f32x2* T2 = (const LAS f32x2*)(lds + HY_T2);
    const bf16* ZT = (const bf16*)(ws + WS_ZT);
    const bf16* r0 = ZT + (size_t)c * ZTP; const bf16* r1 = ZT + (size_t)(HYW + c) * ZTP; const bf16* r2 = ZT + (size_t)(2 * HYW + c) * ZTP;
    const float* cw = a.in[I_CONVW]; const float* cb = a.in[I_CONVB];
    const float w00 = cw[c], w01 = cw[HYIN + c], w02 = cw[2 * HYIN + c], b0 = cb[c];
    const float w10 = cw[HYW + c], w11 = cw[HYIN + HYW + c], w12 = cw[2 * HYIN + HYW + c], b1 = cb[HYW + c];
    const float w20 = cw[2 * HYW + c], w21 = cw[HYIN + 2 * HYW + c], w22 = cw[2 * HYIN + 2 * HYW + c], b2 = cb[2 * HYW + c];
    unsigned uq[16], xq[16];
    const float skip = a.in[I_SKIP][c];
#pragma unroll
    for (int kb = 0; kb < 16; kb += 4) {
        unsigned wd[4][3][3];
#pragma unroll
        for (int k = 0; k < 4; ++k) {
            const int t = 2 * (tid + NTHR * (kb + k)); const int tp = t > 0 ? t - 2 : 0;
            wd[k][0][0] = *(const unsigned*)(r0 + tp); wd[k][0][1] = *(const unsigned*)(r0 + t); wd[k][0][2] = *(const unsigned*)(r0 + t + 2);
            wd[k][1][0] = *(const unsigned*)(r1 + tp); wd[k][1][1] = *(const unsigned*)(r1 + t); wd[k][1][2] = *(const unsigned*)(r1 + t + 2);
            wd[k][2][0] = *(const unsigned*)(r2 + tp); wd[k][2][1] = *(const unsigned*)(r2 + t); wd[k][2][2] = *(const unsigned*)(r2 + t + 2);
        }
#pragma unroll
        for (int k = 0; k < 4; ++k) {
            const int n = tid + NTHR * (kb + k), t = 2 * n;
            const f32x2 x0v = conv3_pair(wd[k][0][0], wd[k][0][1], wd[k][0][2], t, w00, w01, w02, b0);
            const f32x2 x1v = conv3_pair(wd[k][1][0], wd[k][1][1], wd[k][1][2], t, w10, w11, w12, b1), hvv = conv3_pair(wd[k][2][0], wd[k][2][1], wd[k][2][2], t, w20, w21, w22, b2);
            const f32x2 uv = hvv * x1v;
            xq[kb + k] = cvt_pk_bf16(x0v.x, x0v.y); uq[kb + k] = cvt_pk_bf16(uv.x * skip, uv.y * skip);
            buf[fpad(n)] = uv;
        }
        asm volatile("" ::: "memory");
    }
    __syncthreads();
    FFT_FWD_H(buf, tid, NTHR, T1, T2, __syncthreads());
    fft_pointwise(buf, (const u32x2*)(ws + WS_KS) + (size_t)c * KSP, tid, NTHR, T1, T2);
    __syncthreads();
    FFT_INV_H(buf, tid, NTHR, T1, T2, __syncthreads());
    bf16* YHT = (bf16*)(ws + WS_YHT) + (size_t)c * SEQ;
#pragma unroll
    for (int k = 0; k < 16; ++k) {
        const int n = tid + NTHR * k; const f32x2 y = buf[fpad(n)];
        *(unsigned*)(YHT + 2 * n) = cvt_pk_bf16(bflo(xq[k]) * (y.x + bflo(uq[k])), bfhi(xq[k]) * (y.y + bfhi(uq[k])));
    }
    __syncthreads();
}

constexpr int AT_KP = 136, AT_VP = 72;
constexpr int AT_KB = 64 * AT_KP * 2, AT_VB = 128 * AT_VP * 2;
DEV void phase_attn(unsigned char* ws, const float* sink, LAS unsigned char* lds, int bid, int nb, int tid) {
    const int w = __builtin_amdgcn_readfirstlane(tid >> 6), lane = tid & 63, c = lane & 31, hi = lane >> 5;
    const bf16* QK = (const bf16*)(ws + WS_QK); const bf16* ZT = (const bf16*)(ws + WS_ZT); bf16* Y = (bf16*)(ws + WS_YMIX);
    const float CS = 0.08838834764831845f * 1.4426950408889634f;
    const int ub = (nb & 7) ? bid : (bid & 7) * (nb >> 3) + (bid >> 3);
    for (int unit = ub; unit < 512; unit += nb) {
        const int qb = unit >> 1, kvh = unit & 1, q0 = qb * 64, h = kvh * 4 + (w >> 1), a0 = (w & 1) * 32, t = q0 + a0 + c;
        const int jlo = (2 - qb) > 0 ? (2 - qb) : 0, jhi = (257 - qb) < 4 ? (257 - qb) : 4, ntile = 4 + (jhi - jlo + 1);
        bf16x8 Qf[8];
#pragma unroll
        for (int ds = 0; ds < 8; ++ds) Qf[ds] = *(const bf16x8*)(QK + (size_t)t * NQK + h * 128 + ds * 16 + hi * 8);
        f32x16 O[4];
#pragma unroll
        for (int db = 0; db < 4; ++db)
#pragma unroll
            for (int r = 0; r < 16; ++r) O[db][r] = 0.f;
        float m = sink[h] * 1.4426950408889634f, l = (hi == 0) ? 1.0f : 0.0f;
        u32x4 stg[4];
        const int kr0 = (tid * 2) >> 4, kc0 = (tid * 2) & 15, vr0 = (tid * 2) >> 3, vc0 = (tid * 2) & 7;
#define AT_TOK(i) ((i) < 4 ? SEQ + 64 * (i) : q0 + (jlo + (i) - 4 - 2) * 64)
#define AT_LOAD(i) do { const int tok_ = AT_TOK(i); \
            stg[0] = *(const u32x4*)(QK + (size_t)(tok_ + kr0) * NQK + 1024 + kvh * 128 + kc0 * 8); stg[1] = *(const u32x4*)(QK + (size_t)(tok_ + kr0) * NQK + 1024 + kvh * 128 + kc0 * 8 + 8); \
            stg[2] = *(const u32x4*)(ZT + (size_t)(HYIN + kvh * 128 + vr0) * ZTP + tok_ + vc0 * 8); stg[3] = *(const u32x4*)(ZT + (size_t)(HYIN + kvh * 128 + vr0) * ZTP + tok_ + vc0 * 8 + 8); } while (0)
#define AT_STORE(b) do { *(LAS u32x4*)(lds + (b) * AT_KB + kr0 * (AT_KP * 2) + kc0 * 16) = stg[0]; *(LAS u32x4*)(lds + (b) * AT_KB + kr0 * (AT_KP * 2) + kc0 * 16 + 16) = stg[1]; \
            *(LAS u32x4*)(lds + 2 * AT_KB + (b) * AT_VB + vr0 * (AT_VP * 2) + vc0 * 16) = stg[2]; *(LAS u32x4*)(lds + 2 * AT_KB + (b) * AT_VB + vr0 * (AT_VP * 2) + vc0 * 16 + 16) = stg[3]; } while (0)
        AT_LOAD(0); AT_STORE(0);
        __syncthreads();
        for (int i = 0; i < ntile; ++i) {
            const int b = i & 1;
            if (i + 1 < ntile) AT_LOAD(i + 1);
            const int jj = (i < 4) ? 2 : (jlo + i - 4);
            const LAS unsigned char* Kb = lds + b * AT_KB; const LAS unsigned char* Vb = lds + 2 * AT_KB + b * AT_VB;
            f32x16 S[2];
#pragma unroll
            for (int kb2 = 0; kb2 < 2; ++kb2) {
#pragma unroll
                for (int r = 0; r < 16; ++r) S[kb2][r] = 0.f;
#pragma unroll
                for (int ds = 0; ds < 8; ++ds) { const bf16x8 kf = *(const LAS bf16x8*)(Kb + (kb2 * 32 + c) * (AT_KP * 2) + ds * 32 + hi * 16); S[kb2] = __builtin_amdgcn_mfma_f32_32x32x16_bf16(kf, Qf[ds], S[kb2], 0, 0, 0); }
            }
            if (jj == 0 || jj == 4) {
                const int a = a0 + c;
#pragma unroll
                for (int kb2 = 0; kb2 < 2; ++kb2)
#pragma unroll
                    for (int r = 0; r < 16; ++r) { const int kk = kb2 * 32 + (r & 3) + 8 * (r >> 2) + 4 * hi; const bool ok = (jj == 0) ? (kk >= a) : (kk <= a); S[kb2][r] = ok ? S[kb2][r] : -INFINITY; }
            }
            float mx = -INFINITY;
#pragma unroll
            for (int kb2 = 0; kb2 < 2; ++kb2)
#pragma unroll
                for (int r = 0; r < 16; r += 2) mx = fmaxf(fmaxf(mx, S[kb2][r]), S[kb2][r + 1]);
            mx = fmaxf(mx, __shfl_xor(mx, 32)) * CS;
            const float mn = fmaxf(m, mx), alpha = __builtin_amdgcn_exp2f(m - mn);
            m = mn;
            f32x2 ps2 = {0.f, 0.f};
#pragma unroll
            for (int kb2 = 0; kb2 < 2; ++kb2)
#pragma unroll
                for (int r = 0; r < 16; r += 2) {
                    const f32x2 tt = (f32x2){S[kb2][r], S[kb2][r + 1]} * CS - mn;
                    f32x2 p; p.x = __builtin_amdgcn_exp2f(tt.x); p.y = __builtin_amdgcn_exp2f(tt.y);
                    S[kb2][r] = p.x; S[kb2][r + 1] = p.y; ps2 += p;
                }
            l = l * alpha + (ps2.x + ps2.y);
#pragma unroll
            for (int db = 0; db < 4; ++db) O[db] *= alpha;
#pragma unroll
            for (int kk = 0; kk < 4; ++kk) {
                const int kb2 = kk >> 1, r0 = (kk & 1) * 8;
                u32x4 pw; pw.x = cvt_pk_bf16(S[kb2][r0], S[kb2][r0 + 1]); pw.y = cvt_pk_bf16(S[kb2][r0 + 2], S[kb2][r0 + 3]); pw.z = cvt_pk_bf16(S[kb2][r0 + 4], S[kb2][r0 + 5]); pw.w = cvt_pk_bf16(S[kb2][r0 + 6], S[kb2][r0 + 7]);
                bf16x8 pf; __builtin_memcpy(&pf, &pw, 16);
#pragma unroll
                for (int db = 0; db < 4; ++db) {
                    const LAS unsigned char* vp = Vb + (db * 32 + c) * (AT_VP * 2) + kk * 32 + hi * 8;
                    const u32x2 v0 = *(const LAS u32x2*)vp, v1 = *(const LAS u32x2*)(vp + 16);
                    u32x4 vw; vw.x = v0.x; vw.y = v0.y; vw.z = v1.x; vw.w = v1.y;
                    bf16x8 vf; __builtin_memcpy(&vf, &vw, 16);
                    O[db] = __builtin_amdgcn_mfma_f32_32x32x16_bf16(vf, pf, O[db], 0, 0, 0);
                }
            }
            if (i + 1 < ntile) AT_STORE(b ^ 1);
            __syncthreads();
        }
        const float lt = l + __shfl_xor(l, 32), inv = 1.0f / lt;
        bf16* yrow = Y + (size_t)t * D + HYW + h * 128;
#pragma unroll
        for (int db = 0; db < 4; ++db)
#pragma unroll
            for (int rq = 0; rq < 4; ++rq) {
                u32x2 o; o.x = cvt_pk_bf16(O[db][rq * 4] * inv, O[db][rq * 4 + 1] * inv); o.y = cvt_pk_bf16(O[db][rq * 4 + 2] * inv, O[db][rq * 4 + 3] * inv);
                *(u32x2*)(yrow + db * 32 + 8 * rq + 4 * hi) = o;
            }
#undef AT_TOK
#undef AT_LOAD
#undef AT_STORE
    }
}
DEV void phase_mixer(const Args& a, unsigned char* ws, LAS unsigned char* lds, int bid, int nb, int tid) {
    hyena_tables(lds, tid);
    for (int c = bid; c < HYW; c += nb) hyena_channel(a, ws, c, lds, bid, tid);
    phase_attn(ws, a.in[I_SINK], lds, bid, nb, tid);
}
DEV void phase_transpose(const Args& a, unsigned char* ws, LAS unsigned char* lds, int bid, int nb, int tid) {
    LAS unsigned* T = (LAS unsigned*)lds;
    const LAS unsigned short* Th = (const LAS unsigned short*)lds;
    const bf16* YHT = (const bf16*)(ws + WS_YHT); bf16* Y = (bf16*)(ws + WS_YMIX);
    constexpr int NT = (HYW / 128) * (SEQ / 128);
    u32x4 v[4];
#define TR_LOAD(tile_) do { const int ct_ = (tile_) & 7, tt_ = (tile_) >> 3; _Pragma("unroll") for (int it = 0; it < 4; ++it) { const int item = it * NTHR + tid, cr = item >> 4, oc = item & 15; \
        v[it] = *(const u32x4*)(YHT + (size_t)(ct_ * 128 + cr) * SEQ + tt_ * 128 + oc * 8); } } while (0)
    if (bid < NT) TR_LOAD(bid);
    for (int tile = bid; tile < NT; tile += nb) {
        const int ct = tile & 7, tt = tile >> 3;
#pragma unroll
        for (int it = 0; it < 4; ++it) { const int item = it * NTHR + tid, cr = item >> 4, oc = item & 15; LAS unsigned* p = T + cr * 65 + oc * 4; p[0] = v[it].x; p[1] = v[it].y; p[2] = v[it].z; p[3] = v[it].w; }
        __syncthreads();
        if (tile + nb < NT) TR_LOAD(tile + nb);
#pragma unroll
        for (int it = 0; it < 4; ++it) {
            const int item = it * NTHR + tid, oct = item & 15, tl = item >> 4;
            unsigned short e[8];
#pragma unroll
            for (int i = 0; i < 8; ++i) e[i] = Th[(oct * 8 + i) * 130 + tl];
            u32x4 w; w.x = e[0] | ((unsigned)e[1] << 16); w.y = e[2] | ((unsigned)e[3] << 16); w.z = e[4] | ((unsigned)e[5] << 16); w.w = e[6] | ((unsigned)e[7] << 16);
            *(u32x4*)(Y + (size_t)(tt * 128 + tl) * D + ct * 128 + oct * 8) = w;
        }
        __syncthreads();
    }
#undef TR_LOAD
}
DEV void phase_spatial(const Args& a, unsigned char* ws, LAS unsigned char* lds, int bid, int nb, int tid) {
    constexpr int AP = 136, VP = 264;
    constexpr int OFF_V = 128 * AP * 2, OFF_RS = OFF_V + 128 * VP * 2;
    LAS float* rs = (LAS float*)(lds + OFF_RS);
    const float* RSV = (const float*)(ws + WS_CTL + CTL_RS) + 5 * SEQ;
    const bf16* V = (const bf16*)(ws + WS_VT); const bf16* U = (const bf16*)(ws + WS_U); bf16* G = (bf16*)(ws + WS_YMIX);
    const int w = __builtin_amdgcn_readfirstlane(tid >> 6), lane = tid & 63, fr = lane & 15, fq = lane >> 4;
    u32x4 vst[8];
#define SP_LOADV(un) do { const int n_ = (un) >> 3, g_ = (un) & 7; _Pragma("unroll") for (int it = 0; it < 8; ++it) { const int item = it * NTHR + tid, q = item >> 5, pc = item & 31; \
        vst[it] = *(const u32x4*)(V + (size_t)(n_ * 128 + q) * D + g_ * 256 + pc * 8); } } while (0)
    if (bid < 1024) SP_LOADV(bid);
    for (int unit = bid; unit < 1024; unit += nb) {
        const int n = unit >> 3, g = unit & 7;
        if (tid < 128) rs[tid] = rsq_f(RSV[n * 128 + tid]);
        u32x4 uq[8];
#pragma unroll
        for (int m = 0; m < 8; ++m) uq[m] = *(const u32x4*)(U + (size_t)(n * 128 + m * 16 + fr) * D + g * 256 + w * 32 + 8 * fq);
        const float* wsg = a.in[I_SGWS] + (size_t)g * 128 * 128;
        f32x4 wq[8];
#pragma unroll
        for (int it = 0; it < 8; ++it) wq[it] = *(const f32x4*)(wsg + (it * NTHR + tid) * 4);
        __syncthreads();
#pragma unroll
        for (int it = 0; it < 8; ++it) {
            const int e = (it * NTHR + tid) * 4, p = e >> 7, q = e & 127;
            const f32x4 rv = *(const LAS f32x4*)(rs + q);
            u32x2 o; o.x = cvt_pk_bf16(wq[it][0] * rv[0], wq[it][1] * rv[1]); o.y = cvt_pk_bf16(wq[it][2] * rv[2], wq[it][3] * rv[3]);
            *(LAS u32x2*)(lds + (p * AP + q) * 2) = o;
        }
#pragma unroll
        for (int it = 0; it < 8; ++it) { const int item = it * NTHR + tid, q = item >> 5, pc = item & 31; *(LAS u32x4*)(lds + OFF_V + (q * VP + pc * 8) * 2) = vst[it]; }
        __syncthreads();
        if (unit + nb < 1024) SP_LOADV(unit + nb);
        const LAS unsigned short* Vs = (const LAS unsigned short*)(lds + OFF_V);
        f32x4 acc[8][2];
#pragma unroll
        for (int m = 0; m < 8; ++m)
#pragma unroll
            for (int nf = 0; nf < 2; ++nf) acc[m][nf] = (f32x4){0.f, 0.f, 0.f, 0.f};
#pragma unroll
        for (int ks = 0; ks < 4; ++ks) {
            bf16x8 Bf[2];
#pragma unroll
            for (int nf = 0; nf < 2; ++nf) {
                const LAS unsigned short* vp = Vs + (ks * 32 + fq * 8) * VP + w * 32 + pg8::perm32(nf * 16 + fr);
                u32x4 t; t.x = vp[0] | ((unsigned)vp[VP] << 16); t.y = vp[2 * VP] | ((unsigned)vp[3 * VP] << 16); t.z = vp[4 * VP] | ((unsigned)vp[5 * VP] << 16); t.w = vp[6 * VP] | ((unsigned)vp[7 * VP] << 16);
                __builtin_memcpy(&Bf[nf], &t, 16);
            }
#pragma unroll
            for (int m = 0; m < 8; ++m) {
                const bf16x8 af = *(const LAS bf16x8*)(lds + ((m * 16 + fr) * AP + ks * 32 + fq * 8) * 2);
#pragma unroll
                for (int nf = 0; nf < 2; ++nf) acc[m][nf] = __builtin_amdgcn_mfma_f32_16x16x32_bf16(Bf[nf], af, acc[m][nf], 0, 0, 0);
            }
        }
        {
            const int c0 = g * 256 + w * 32 + 8 * fq;
            const f32x4 sg0 = *(const f32x4*)(a.in[I_SGG] + c0), sg1 = *(const f32x4*)(a.in[I_SGG] + c0 + 4);
#pragma unroll
            for (int m = 0; m < 8; ++m) {
                const int p = m * 16 + fr, t = n * 128 + p;
                const float bsv = a.in[I_SGBS][g * 128 + p];
                const u32x4 uw = uq[m];
                const f32x4 m0 = acc[m][0] * sg0 + bsv, m1 = acc[m][1] * sg1 + bsv;
                u32x4 o; o.x = cvt_pk_bf16(bflo(uw.x) * m0[0], bfhi(uw.x) * m0[1]); o.y = cvt_pk_bf16(bflo(uw.y) * m0[2], bfhi(uw.y) * m0[3]);
                o.z = cvt_pk_bf16(bflo(uw.z) * m1[0], bfhi(uw.z) * m1[1]); o.w = cvt_pk_bf16(bflo(uw.w) * m1[2], bfhi(uw.w) * m1[3]);
                *(u32x4*)(G + (size_t)t * D + c0) = o;
            }
        }
    }
#undef SP_LOADV
}

constexpr int NPHASE = 19;
__global__ void __launch_bounds__(NTHR, 2) fwd(Args a) {
    extern __shared__ __attribute__((aligned(16))) unsigned char lds_raw[];
    LAS unsigned char* lds = (LAS unsigned char*)lds_raw;
    const int tid = threadIdx.x, bid = blockIdx.x, nb = gridDim.x;
    const int lo = a.ph_lo, hi = a.ph_hi;
    volatile LAS unsigned* xbw = (volatile LAS unsigned*)(lds + LDS_BYTES - 16);
    if (tid < 4) xbw[tid] = 0u;
    __syncthreads();
    XcdBarrier bar; bar.bar = (unsigned*)(a.ws + WS_CTL) + 4096; bar.x = 0; bar.st = xbw;
    if (!MK_PER_PHASE) bar = xcd_barrier_post((unsigned*)(a.ws + WS_CTL) + 4096, xbw);
#ifndef PH_MASK
#define PH_MASK 0x7ffffu
#endif
#define IN(k) ((((PH_MASK) >> (k)) & 1u) && lo <= (k) && (k) < hi)
#define SEAM(k) do { if (!MK_PER_PHASE) xcd_barrier(bar); } while (0)
#define PH_VARS unsigned char* ws = fresh_ptr(a.ws); float* mod = (float*)(ws + WS_MOD); \
    const float* mod0l = mod, *mod0c = mod + NMOD * D, *mod1l = mod + 2 * NMOD * D, *mod1c = mod + 3 * NMOD * D; \
    bf16* XN = (bf16*)(ws + WS_XN); bf16* ACT = (bf16*)(ws + WS_ACT); float* XC = (float*)(ws + WS_XC); \
    const bf16* WGU = (const bf16*)(ws + WS_WGU); const bf16* WD = (const bf16*)(ws + WS_WD); float* X = (float*)fresh_ptr((unsigned char*)a.out); \
    bf16* XB = (bf16*)(ws + WS_XB); (void)XB; const float* SW = (const float*)(ws + WS_SW); float* RS = (float*)(ws + WS_CTL + CTL_RS); const bf16* YMIX = (const bf16*)(ws + WS_YMIX); (void)SW; (void)RS; (void)YMIX; \
    (void)mod0l; (void)mod0c; (void)mod1l; (void)mod1c; (void)XN; (void)ACT; (void)XC; (void)WGU; (void)WD; (void)X;

    if (IN(0)) { PH_VARS phase_prologue(a, ws, lds, bid, nb, tid); SEAM(0); }
    if (IN(1)) { PH_VARS phase_filter_fft(a, ws, lds, bid, nb, tid); __syncthreads(); }
    if (IN(2)) { PH_VARS
        {
            f32x4 va[8], vb[8]; int t = a.ncvt_p1 + bid;
            if (t < a.ncvt) { int ja = cvt_job_of(a, t); cvt_issue(a.jobs[ja], t - a.jobs[ja].tile0, tid, va);
                for (;;) {
                    const int t2 = t + nb; int jb = 0; const bool h2 = t2 < a.ncvt;
                    if (h2) { jb = cvt_job_of(a, t2); cvt_issue(a.jobs[jb], t2 - a.jobs[jb].tile0, tid, vb); }
                    cvt_finish(a.jobs[ja], t - a.jobs[ja].tile0, tid, va);
                    if (!h2) break;
                    const int t3 = t2 + nb; const bool h3 = t3 < a.ncvt;
                    if (h3) { ja = cvt_job_of(a, t3); cvt_issue(a.jobs[ja], t3 - a.jobs[ja].tile0, tid, va); }
                    cvt_finish(a.jobs[jb], t2 - a.jobs[jb].tile0, tid, vb);
                    if (!h3) break;
                    t = t3;
                } }
        }
        phase_norm(a.in[I_X], a.in[I_CTX], MTOT, a.in[I_NORMG] + 0 * D, mod0l, mod0c, 0, XN, XC, lds, bid, nb, tid); SEAM(2); }
    if (IN(3)) { PH_VARS pg8::Gemm g{XN, WGU, D, D, D, nullptr, nullptr}; pg8::StaticOrder S; S.init(65, NGU / 256, nb, bid); EpiSwiGLU<false> E{ACT, FF, lds, 0}; pg8::gemm_phase(lds, g, S, E); SEAM(3); }
    if (IN(4)) { PH_VARS
        { pg8::Gemm g{ACT, WD, FF, FF, FF, nullptr, nullptr}; pg8::StaticOrder S; S.init(64, D / 256, nb, bid); EpiRes<true, true, true> E{a.in[I_X], XB, mod0l + 2 * D, RS + 0 * SEQ}; pg8::gemm_phase(lds, g, S, E); }
        { pg8::Gemm g{ACT, WD, FF / 4, FF, FF, nullptr, nullptr}; SplitOrder S{nb, bid}; EpiResAtomic E{XC, mod0c + 2 * D, 0.5f}; pg8::gemm_phase(lds, g, S, E); }
        SEAM(4);
    }
    if (IN(5)) { PH_VARS
        constexpr int NZ = (NZT / 256) * (SEQ / 256), NQ = (SEQ / 256) * (NQK / 256);
        {
            pg8::Gemm g{(const bf16*)(ws + WS_WIN), XB, D, D, D, XB, (const bf16*)(ws + WS_WIN) + (size_t)NZT * D};
            pg8::DualOrder S; S.s0.init(NZT / 256, SEQ / 256, 1, 0); S.s1.init(SEQ / 256, NQK / 256, 1, 0); S.n0 = NZ; S.n1 = NQ; S.G = nb; S.c = bid; S.nE = 0;
            S.et0 = S.et1 = 0; S.epm0 = S.epm1 = 0; S.epn0 = S.epn1 = 0; S.dlo = 4 * nb - 2; S.dn = 2;
            pg8::EpiDual<EpiT<false>, EpiQKV> E{{(bf16*)(ws + WS_ZT), ZTP, RS + 0 * SEQ, SW + SW_IN0, nullptr}, {(bf16*)(ws + WS_QK), (const f32x2*)(ws + WS_ROPE), RS + 0 * SEQ, SW + SW_IN0 + NZT}};
            pg8::gemm_phase(lds, g, S, E);
        }
        if (bid >= nb - 2) {
            ctx_norm_block(XC, a.in[I_NORMG] + 1 * D, mod0c, 3, XN + (size_t)SEQ * D, tid, lds);
            const bf16* WC = (const bf16*)(ws + WS_WINC);
            pg8::Gemm g{WC - (size_t)12 * 256 * D, XN, D, D, D, XN, WC + (size_t)256 * D - (size_t)4 * 256 * D};
            pg8::DualOrder S; S.s0.init(1, 1, 1, 0); S.s1.init(1, 1, 1, 0); S.n0 = 0; S.n1 = 0; S.G = 2; S.c = bid - (nb - 2); S.nE = 2; S.dlo = 0; S.dn = 0;
            S.et0 = 0; S.epm0 = 12; S.epn0 = 64; S.et1 = 1; S.epm1 = 64; S.epn1 = 4;
            pg8::EpiDual<EpiT<false>, EpiQKV> E{{(bf16*)(ws + WS_ZT), ZTP, RS + 0 * SEQ, SW + SW_IN0, nullptr}, {(bf16*)(ws + WS_QK), (const f32x2*)(ws + WS_ROPE), RS + 0 * SEQ, SW + SW_IN0 + NZT}};
            pg8::gemm_phase(lds, g, S, E);
        }
        SEAM(5);
    }
    if (IN(6)) { PH_VARS phase_mixer(a, ws, lds, bid, nb, tid); SEAM(6); }
    if (IN(7)) { PH_VARS phase_transpose(a, ws, lds, bid, nb, tid); SEAM(7); }
    if (IN(8)) { PH_VARS pg8::Gemm g{YMIX, (const bf16*)(ws + WS_WOE), D, D, D, nullptr, nullptr}; pg8::StaticOrder S; S.init(SEQ / 256, D / 256, nb, bid); EpiRes<true, false, false> E{XB, XB, mod0l + 5 * D, RS + 1 * SEQ}; pg8::gemm_phase(lds, g, S, E); SEAM(8); }
    if (IN(9)) { PH_VARS pg8::Gemm g{XB, WGU + (size_t)NGU * D, D, D, D, nullptr, nullptr}; pg8::StaticOrder S; S.init(64, NGU / 256, nb, bid); { pg8::Unit u0; S.next(0, u0); const int rowbase = (u0.pm & ~7) * 256; stage_gateup_tables(RS + 1 * SEQ, SW + SW_GU1, rowbase, lds, tid); EpiSwiGLU<true> E{ACT, FF, lds, rowbase}; pg8::gemm_phase(lds, g, S, E); } SEAM(9); }
    if (IN(10)) { PH_VARS pg8::Gemm g{ACT, WD + (size_t)D * FF, FF, FF, FF, nullptr, nullptr}; pg8::StaticOrder S; S.init(64, D / 256, nb, bid); EpiRes<true, true, false> E{XB, XB, mod0l + 8 * D, RS + 2 * SEQ}; pg8::gemm_phase(lds, g, S, E); SEAM(10); }
    if (IN(11)) { PH_VARS pg8::Gemm g{XB, WGU + 2 * (size_t)NGU * D, D, D, D, nullptr, nullptr}; pg8::StaticOrder S; S.init(64, NGU / 256, nb, bid); { pg8::Unit u0; S.next(0, u0); const int rowbase = (u0.pm & ~7) * 256; stage_gateup_tables(RS + 2 * SEQ, SW + SW_GU2, rowbase, lds, tid); EpiSwiGLU<true> E{ACT, FF, lds, rowbase}; pg8::gemm_phase(lds, g, S, E); } SEAM(11); }
    if (IN(12)) { PH_VARS pg8::Gemm g{ACT, WD + 2 * (size_t)D * FF, FF, FF, FF, nullptr, nullptr}; pg8::StaticOrder S; S.init(64, D / 256, nb, bid); EpiRes<true, true, false> E{XB, XB, mod1l + 2 * D, RS + 3 * SEQ}; pg8::gemm_phase(lds, g, S, E); SEAM(12); }
    if (IN(13)) { PH_VARS
        { pg8::Gemm g{XB, (const bf16*)(ws + WS_WODI), D, D, D, nullptr, nullptr}; pg8::StaticOrder S; S.init(SEQ / 256, 2 * D / 256, nb, bid);
          EpiGeluUV E{(bf16*)(ws + WS_U), (bf16*)(ws + WS_VT), RS + 3 * SEQ, SW + SW_IN1, RS + 5 * SEQ}; pg8::gemm_phase(lds, g, S, E); }
        SEAM(13);
    }
    if (IN(14)) { PH_VARS phase_spatial(a, ws, lds, bid, nb, tid); SEAM(14); }
    if (IN(15)) { PH_VARS pg8::Gemm g{YMIX, (const bf16*)(ws + WS_WODO), D, D, D, nullptr, nullptr}; pg8::StaticOrder S; S.init(SEQ / 256, D / 256, nb, bid); EpiRes<true, false, false> E{XB, XB, mod1l + 5 * D, RS + 4 * SEQ}; pg8::gemm_phase(lds, g, S, E); SEAM(15); }
    if (IN(16)) { PH_VARS pg8::Gemm g{XB, WGU + 3 * (size_t)NGU * D, D, D, D, nullptr, nullptr}; pg8::StaticOrder S; S.init(64, NGU / 256, nb, bid); { pg8::Unit u0; S.next(0, u0); const int rowbase = (u0.pm & ~7) * 256; stage_gateup_tables(RS + 4 * SEQ, SW + SW_GU3, rowbase, lds, tid); EpiSwiGLU<true> E{ACT, FF, lds, rowbase}; pg8::gemm_phase(lds, g, S, E); } SEAM(16); }
    if (IN(17)) { PH_VARS pg8::Gemm g{ACT, WD + 3 * (size_t)D * FF, FF, FF, FF, nullptr, nullptr}; pg8::StaticOrder S; S.init(64, D / 256, nb, bid); EpiRes<false, true, false> E{XB, XB, mod1l + 8 * D, nullptr}; pg8::gemm_phase(lds, g, S, E); SEAM(17); }
    if (IN(18)) { PH_VARS phase_final_norm(XB, X, a.in[I_FING], bid, nb, tid); }
#undef IN
#undef SEAM
}

extern "C" void kernel_launch(void* const* d_in, const int* in_sizes, int n_in, void* d_out, int out_size, void* d_ws, size_t ws_size, hipStream_t stream) {
    static int grid = 0;
    if (grid == 0) {
        if (n_in != 29 || out_size != SEQ * D || ws_size < WS_END) { fprintf(stderr, "kernel_launch: unexpected problem (n_in %d, out %d, ws %zu < %zu)\n", n_in, out_size, ws_size, (size_t)WS_END); grid = -1; return; }
        int dev = 0, cus = 0;
        if (hipGetDevice(&dev) != hipSuccess || hipDeviceGetAttribute(&cus, hipDeviceAttributeMultiprocessorCount, dev) != hipSuccess) { grid = -1; return; }
        if (hipFuncSetAttribute((const void*)fwd, hipFuncAttributeMaxDynamicSharedMemorySize, LDS_BYTES) != hipSuccess) { fprintf(stderr, "kernel_launch: hipFuncSetAttribute failed\n"); grid = -1; return; }
        int per_cu = 0;
        if (hipOccupancyMaxActiveBlocksPerMultiprocessor(&per_cu, (const void*)fwd, NTHR, LDS_BYTES) != hipSuccess || per_cu < 1) fprintf(stderr, "kernel_launch: occupancy query says %d\n", per_cu);
        (void)hipGetLastError();
        grid = cus;
    }
    if (grid < 0) return;
    (void)hipMemsetAsync((char*)d_ws + WS_CTL, 0, CTL_ZERO_BYTES, stream);
    Args a{};
    for (int i = 0; i < 29; ++i) a.in[i] = (const float*)d_in[i];
    a.out = (float*)d_out; a.ws = (unsigned char*)d_ws;
    unsigned char* ws = (unsigned char*)d_ws;
    int nj = 0, tiles = 0;
    auto add = [&](const float* src, bf16* dst, int K, int N, int kind, const float* shift, float* sw, const float* fg, const float* fs, bf16* dst2) {
        a.jobs[nj].src = src; a.jobs[nj].dst = dst; a.jobs[nj].shift = shift; a.jobs[nj].sw = sw; a.jobs[nj].fg = fg; a.jobs[nj].fs = fs; a.jobs[nj].dst2 = dst2;
        a.jobs[nj].K = K; a.jobs[nj].N = N; a.jobs[nj].kind = kind; a.jobs[nj].tile0 = tiles; tiles += (K / 128) * (N / 128); ++nj; };
    const float* modp = (const float*)(ws + WS_MOD); const float* m0l = modp; const float* m1l = modp + 2 * NMOD * D;
    const float* ng = a.in[I_NORMG];
    float* SWp = (float*)(ws + WS_SW);
    auto wgu = [&](int f) { return (bf16*)(ws + WS_WGU + f * WGU_SZ); };
    add(a.in[I_WG], wgu(0), D, FF, 1, nullptr, nullptr, nullptr, nullptr, nullptr); add(a.in[I_WU], wgu(0), D, FF, 2, nullptr, nullptr, nullptr, nullptr, nullptr);
    for (int f = 0; f < 4; ++f) add(a.in[I_WD] + (size_t)f * FF * D, (bf16*)(ws + WS_WD + f * WD_SZ), FF, D, 0, nullptr, nullptr, nullptr, nullptr, nullptr);
    add(a.in[I_EVWOUT], (bf16*)(ws + WS_WOE), D, D, 0, nullptr, nullptr, nullptr, nullptr, nullptr);
    add(a.in[I_ODWOUT], (bf16*)(ws + WS_WODO), D, D, 0, nullptr, nullptr, nullptr, nullptr, nullptr);
    a.ncvt_early = tiles;
    add(a.in[I_EVWIN], (bf16*)(ws + WS_WIN), D, INEV, 3, m0l + 3 * D, SWp + SW_IN0, ng + 1 * D, m0l + 4 * D, (bf16*)(ws + WS_WINC));
    { const float* sh[4] = {nullptr, m0l + 6 * D, m1l + 0 * D, m1l + 6 * D}; const float* fgv[4] = {nullptr, ng + 2 * D, ng + 3 * D, ng + 5 * D}; const float* fsv[4] = {nullptr, m0l + 7 * D, m1l + 1 * D, m1l + 7 * D};
      const int so[4] = {0, SW_GU1, SW_GU2, SW_GU3};
      for (int f = 1; f < 4; ++f) { add(a.in[I_WG] + (size_t)f * D * FF, wgu(f), D, FF, 1, sh[f], SWp + so[f], fgv[f], fsv[f], nullptr); add(a.in[I_WU] + (size_t)f * D * FF, wgu(f), D, FF, 2, sh[f], SWp + so[f], fgv[f], fsv[f], nullptr);
                                    if (f == 1) a.ncvt_p1 = tiles; } }
    add(a.in[I_ODWIN], (bf16*)(ws + WS_WODI), D, 2 * D, 0, m1l + 3 * D, SWp + SW_IN1, ng + 4 * D, m1l + 4 * D, nullptr);
    a.ncvt = tiles;
#if MK_PER_PHASE
    for (int ph = 0; ph < NPHASE; ++ph) {
        a.ph_lo = ph; a.ph_hi = ph + 1;
        hipLaunchKernelGGL(fwd, dim3(grid), dim3(NTHR), LDS_BYTES, stream, a);
    }
#else
    a.ph_lo = 0; a.ph_hi = NPHASE;
    hipLaunchKernelGGL(fwd, dim3(grid), dim3(NTHR), LDS_BYTES, stream, a);
#endif
    const hipError_t le = hipPeekAtLastError();
    if (le != hipSuccess) fprintf(stderr, "kernel_launch: launch failed: %s\n", hipGetErrorName(le));
}
#endif
```
